# Optimizing an MI355X kernel written in HIP

```python
import math
import jax, jax.numpy as jnp
from jax import lax
import numpy as np

D_MODEL = 1024
BATCH = 8
SEQ = 4096
DEPTH = 2

CHUNK = 64
EPS = 1e-6
RET_HEADS = 4
RET_QK_DIM = 256
RET_V_DIM = 512
RET_Q_COLS = RET_HEADS * RET_QK_DIM
RET_V_COLS = RET_HEADS * RET_V_DIM
RET_IN_COLS = 2 * RET_Q_COLS + 2 * RET_V_COLS
ROPE_BASE = 10000.0
ATT_HEADS = 16
ATT_HEAD_DIM = D_MODEL // ATT_HEADS
PAST_CHUNKS = 8
BAND = (PAST_CHUNKS + 1) * CHUNK
REL_CLIP = 256
REL_TABLE = 2 * REL_CLIP + 1
FFN_HIDDEN = int(math.ceil(math.ceil(8 * D_MODEL / 3) / 256) * 256)

kernel_name = "yoco_retention_chunked_relbias_attention"


def rmsnorm(x, g):
    x32 = x.astype(jnp.float32)
    y = x32 * lax.rsqrt(jnp.mean(x32 * x32, axis=-1, keepdims=True) + EPS)
    return (y * g.astype(jnp.float32)).astype(x.dtype)


def swiglu_ffn(h, w_gu, w_down):
    gate, up = jnp.split(h @ w_gu, 2, axis=-1)
    return (jax.nn.silu(gate) * up) @ w_down


def rope(x, positions):
    half = x.shape[-1] // 2
    inv_freq = ROPE_BASE ** (-jnp.arange(half, dtype=jnp.float32) / half)
    ang = positions.astype(jnp.float32)[:, None] * inv_freq[None, :]
    cos = jnp.cos(ang)[None, :, None, :]
    sin = jnp.sin(ang)[None, :, None, :]
    x1, x2 = x[..., :half], x[..., half:]
    return jnp.concatenate([x1 * cos - x2 * sin, x1 * sin + x2 * cos], axis=-1).astype(x.dtype)


def retention_mixer(h, w_in, gn_g, w_o):
    b, s, _ = h.shape
    n = s // CHUNK
    proj = h @ w_in
    q, k, v, g = jnp.split(proj, [RET_Q_COLS, 2 * RET_Q_COLS, 2 * RET_Q_COLS + RET_V_COLS], axis=-1)
    pos = jnp.arange(s)
    q = rope(q.reshape(b, s, RET_HEADS, RET_QK_DIM), pos)
    k = rope(k.reshape(b, s, RET_HEADS, RET_QK_DIM), pos) * (RET_QK_DIM ** -0.5)
    v = v.reshape(b, s, RET_HEADS, RET_V_DIM)
    to_chunks = lambda t: t.reshape(b, n, CHUNK, RET_HEADS, t.shape[-1]).transpose(1, 0, 3, 2, 4)
    qc, kc, vc = to_chunks(q), to_chunks(k), to_chunks(v)

    log_gamma = jnp.log(1.0 - 2.0 ** (-5.0 - jnp.arange(RET_HEADS, dtype=jnp.float32)))
    lg = log_gamma[:, None]
    t = jnp.arange(CHUNK, dtype=jnp.float32)
    intra = jnp.exp(lg[:, :, None] * jnp.abs(t[:, None] - t[None, :]))
    q_dec = jnp.exp(lg * (t + 1.0))[:, :, None]
    k_dec = jnp.exp(lg * (CHUNK - 1.0 - t))[:, :, None]
    s_dec = jnp.exp(lg * CHUNK)[:, :, None]

    def step(state, inp):
        qi, ki, vi = inp
        scores = jnp.einsum('bhtd,bhsd->bhts', qi, ki) * intra
        o = jnp.einsum('bhts,bhsv->bhtv', scores, vi) + jnp.einsum('bhtd,bhdv->bhtv', qi * q_dec, state)
        state = state * s_dec + jnp.einsum('bhsd,bhsv->bhdv', ki * k_dec, vi)
        return state, o

    state0 = jnp.zeros((b, RET_HEADS, RET_QK_DIM, RET_V_DIM), dtype=jnp.result_type(qc.dtype, intra.dtype))
    _, o = lax.scan(step, state0, (qc, kc, vc))
    o = o.transpose(1, 0, 3, 2, 4).reshape(b, s, RET_HEADS, RET_V_DIM)
    o = rmsnorm(o, gn_g.reshape(RET_HEADS, RET_V_DIM)).reshape(b, s, RET_V_COLS).astype(h.dtype)
    return (jax.nn.silu(g) * o) @ w_o


def shared_kv(h, kv_norm_g, w_kv, k_norm_g):
    b, s, _ = h.shape
    u = rmsnorm(h, kv_norm_g)
    k, v = jnp.split(u @ w_kv, 2, axis=-1)
    k = rmsnorm(k.reshape(b, s, ATT_HEADS, ATT_HEAD_DIM), k_norm_g)
    v = v.reshape(b, s, ATT_HEADS, ATT_HEAD_DIM)
    pad = ((0, 0), (PAST_CHUNKS * CHUNK, 0), (0, 0), (0, 0))
    return jnp.pad(k, pad), jnp.pad(v, pad)


def chunk_band_attention(h, w_q, q_norm_g, rel_bias, w_o, k_pad, v_pad):
    b, s, _ = h.shape
    n = s // CHUNK
    q = rmsnorm((h @ w_q).reshape(b, s, ATT_HEADS, ATT_HEAD_DIM), q_norm_g) * (ATT_HEAD_DIM ** -0.5)
    qc = q.reshape(b, n, CHUNK, ATT_HEADS, ATT_HEAD_DIM).swapaxes(0, 1)
    t = jnp.arange(CHUNK)
    j = jnp.arange(BAND)
    dist = PAST_CHUNKS * CHUNK + t[:, None] - j[None, :]
    bias = rel_bias.astype(jnp.float32)[:, jnp.clip(dist, -REL_CLIP, REL_CLIP) + REL_CLIP]

    def one_chunk(args):
        i, qi = args
        kb = lax.dynamic_slice_in_dim(k_pad, i * CHUNK, BAND, axis=1)
        vb = lax.dynamic_slice_in_dim(v_pad, i * CHUNK, BAND, axis=1)
        sc = jnp.einsum('bthd,bshd->bhts', qi, kb).astype(jnp.float32) + bias
        valid = j >= (PAST_CHUNKS - i) * CHUNK
        sc = jnp.where(valid[None, None, None, :], sc, -jnp.inf)
        p = jax.nn.softmax(sc, axis=-1).astype(vb.dtype)
        return jnp.einsum('bhts,bshd->bthd', p, vb)

    o = lax.map(one_chunk, (jnp.arange(n), qc))
    o = o.swapaxes(0, 1).reshape(b, s, ATT_HEADS * ATT_HEAD_DIM)
    return o @ w_o


def setup_inputs(seed: int = 0) -> dict:
    key = jax.random.key(seed)
    ks = iter(jax.random.split(key, 32))
    n_a = DEPTH // 2
    n_b = DEPTH - n_a
    f32 = jnp.float32

    def w(shape, fan_in):
        return jax.random.normal(next(ks), shape, f32) * (fan_in ** -0.5)

    def gain(shape):
        return 1.0 + 0.1 * jax.random.normal(next(ks), shape, f32)

    return {
        "x": jax.random.normal(next(ks), (BATCH, SEQ, D_MODEL), f32),
        "a_norm_g": gain((n_a, D_MODEL)),
        "a_w_in": w((n_a, D_MODEL, RET_IN_COLS), D_MODEL),
        "a_gn_g": gain((n_a, RET_V_COLS)),
        "a_w_o": w((n_a, RET_V_COLS, D_MODEL), RET_V_COLS),
        "a_ffn_norm_g": gain((n_a, D_MODEL)),
        "a_w_gu": w((n_a, D_MODEL, 2 * FFN_HIDDEN), D_MODEL),
        "a_w_down": w((n_a, FFN_HIDDEN, D_MODEL), FFN_HIDDEN),
        "kv_norm_g": gain((D_MODEL,)),
        "w_kv": w((D_MODEL, 2 * D_MODEL), D_MODEL),
        "k_norm_g": gain((ATT_HEAD_DIM,)),
        "b_norm_g": gain((n_b, D_MODEL)),
        "b_w_q": w((n_b, D_MODEL, D_MODEL), D_MODEL),
        "b_q_norm_g": gain((n_b, ATT_HEAD_DIM)),
        "b_rel_bias": 0.5 * jax.random.normal(next(ks), (n_b, ATT_HEADS, REL_TABLE), f32),
        "b_w_o": w((n_b, D_MODEL, D_MODEL), D_MODEL),
        "b_ffn_norm_g": gain((n_b, D_MODEL)),
        "b_w_gu": w((n_b, D_MODEL, 2 * FFN_HIDDEN), D_MODEL),
        "b_w_down": w((n_b, FFN_HIDDEN, D_MODEL), FFN_HIDDEN),
    }


def reference(x, a_norm_g, a_w_in, a_gn_g, a_w_o, a_ffn_norm_g, a_w_gu, a_w_down,
              kv_norm_g, w_kv, k_norm_g,
              b_norm_g, b_w_q, b_q_norm_g, b_rel_bias, b_w_o, b_ffn_norm_g, b_w_gu, b_w_down):
    n_a = DEPTH // 2
    k_pad = v_pad = None
    for layer in range(DEPTH):
        if layer < n_a:
            i = layer
            x = x + retention_mixer(rmsnorm(x, a_norm_g[i]), a_w_in[i], a_gn_g[i], a_w_o[i])
            x = x + swiglu_ffn(rmsnorm(x, a_ffn_norm_g[i]), a_w_gu[i], a_w_down[i])
        else:
            if layer == n_a:
                k_pad, v_pad = shared_kv(x, kv_norm_g, w_kv, k_norm_g)
            i = layer - n_a
            x = x + chunk_band_attention(rmsnorm(x, b_norm_g[i]), b_w_q[i], b_q_norm_g[i],
                                         b_rel_bias[i], b_w_o[i], k_pad, v_pad)
            x = x + swiglu_ffn(rmsnorm(x, b_ffn_norm_g[i]), b_w_gu[i], b_w_down[i])
    return x
```

```cpp
#include <hip/hip_runtime.h>
#include <cstdio>
#include <cstdint>

typedef unsigned short bf16_t;
typedef short bf16x8 __attribute__((ext_vector_type(8)));
typedef float f32x4 __attribute__((ext_vector_type(4)));
typedef float f32x2 __attribute__((ext_vector_type(2)));
typedef unsigned u32x4 __attribute__((ext_vector_type(4)));
typedef unsigned u32x2 __attribute__((ext_vector_type(2)));

constexpr int BATCH = 8, SEQ = 4096, DM = 1024, MTOK = BATCH * SEQ;
constexpr int CH = 64, NCH = SEQ / CH;
constexpr int RH = 4, RDK = 256, RDV = 512, RQC = 1024, RVC = 2048, RIN = 6144;
constexpr int AH = 16, AHD = 64, PAST = 8, RELCLIP = 256, RELT = 513;
constexpr int FF = 2816;
constexpr float EPS = 1e-6f;
constexpr float LOG2E = 1.4426950408889634f;

constexpr size_t MiB = 1u << 20;
constexpr size_t WS_CTL = 0;
constexpr size_t WS_SS1 = 1 * MiB;
constexpr size_t WS_SS2 = WS_SS1 + 128 * 1024;
constexpr size_t WS_SS3 = WS_SS2 + 128 * 1024;
constexpr size_t WS_SSH = WS_SS1 + 512 * 1024;
constexpr size_t ZERO_BYTES = 2 * MiB;
constexpr size_t WS_SS0 = 2 * MiB;
constexpr size_t WS_COS = 3 * MiB, WS_SIN = 5 * MiB;
constexpr size_t WS_W1 = 8 * MiB, WS_W2 = 20 * MiB, WS_W3 = 24 * MiB, WS_W4 = 35 * MiB, WS_W5 = 41 * MiB, WS_W6 = 47 * MiB, WS_W7 = 49 * MiB, WS_W8 = 60 * MiB;
constexpr size_t WS_Q = 72 * MiB, WS_K = 136 * MiB, WS_V = 200 * MiB, WS_G = 328 * MiB;
constexpr size_t WS_XH1 = 248 * MiB, WS_H = 72 * MiB, WS_XH2 = 328 * MiB;
constexpr size_t WS_K2 = 72 * MiB, WS_V2 = 136 * MiB, WS_Q2 = 200 * MiB, WS_O2 = 264 * MiB, WS_XH3 = 392 * MiB;
constexpr size_t WS_END = 456 * MiB;

struct Ptrs {
    const float *x, *a_norm_g, *a_w_in, *a_gn_g, *a_w_o, *a_ffn_norm_g, *a_w_gu, *a_w_down, *kv_norm_g, *w_kv, *k_norm_g,
                *b_norm_g, *b_w_q, *b_q_norm_g, *b_rel_bias, *b_w_o, *b_ffn_norm_g, *b_w_gu, *b_w_down;
    float* out; unsigned char* ws;
};

__device__ __forceinline__ unsigned f2bf(float f) { unsigned u = __float_as_uint(f); return (u + 0x7fffu + ((u >> 16) & 1u)) >> 16; }
__device__ __forceinline__ unsigned pk2(float lo, float hi) { return f2bf(lo) | (f2bf(hi) << 16); }
__device__ __forceinline__ float bf2f(unsigned short h) { return __uint_as_float((unsigned)h << 16); }
__device__ __forceinline__ float bflo(unsigned w) { return __uint_as_float(w << 16); }
__device__ __forceinline__ float bfhi(unsigned w) { return __uint_as_float(w & 0xffff0000u); }
__device__ __forceinline__ void store8bf(bf16_t* dst, const f32x4 a, const f32x4 b) {
    u32x4 w; w.x = pk2(a[0], a[1]); w.y = pk2(a[2], a[3]); w.z = pk2(b[0], b[1]); w.w = pk2(b[2], b[3]); *(u32x4*)dst = w;
}
__device__ __forceinline__ float rstd_of(float ss, float inv_n) { return 1.0f / sqrtf(ss * inv_n + EPS); }

enum { MAP_ID = 0, MAP_WIN = 1, MAP_GU = 2, MAP_HEAD = 3 };
__device__ __forceinline__ void transpose_item(const float* W, int K, int Nsrc, bf16_t* WT, int dst_row_off, const float* gain, int map, int src_off,
                                               int Ndst, float* scr, int item, int lane) {
    const int nblk = Ndst / 32, kb = item / nblk, nb = item % nblk, k0 = 64 * kb, n0 = 32 * nb;
    int src; float cs = 1.f;
    if (map == MAP_GU) { const int pn = n0 >> 8, c = n0 & 255; src = c < 128 ? 128 * pn + c : FF + 128 * pn + (c - 128); }
    else if (map == MAP_HEAD) { const int pn = n0 >> 8, c = n0 & 255, bj = c >> 7, wc = (c & 127) >> 5; src = src_off + 256 * pn + 64 * wc + 32 * bj; }
    else { src = src_off + n0; if (map == MAP_WIN && n0 >= 1024 && n0 < 2048) cs = 0.0625f; }
#pragma unroll 8
    for (int i = 0; i < 32; ++i) { const int kk = 2 * i + (lane >> 5); float g = gain ? gain[k0 + kk] : 1.f;
        scr[kk * 33 + (lane & 31)] = W[(size_t)(k0 + kk) * Nsrc + src + (lane & 31)] * (g * cs); }
    __builtin_amdgcn_s_waitcnt(0xc07f); asm volatile("" ::: "memory");
    const int c = lane & 7;
#pragma unroll
    for (int j = 0; j < 4; ++j) { const int n = (lane >> 3) + 8 * j; const float* s = scr + (8 * c) * 33 + n;
        u32x4 o; o.x = pk2(s[0 * 33], s[1 * 33]); o.y = pk2(s[2 * 33], s[3 * 33]); o.z = pk2(s[4 * 33], s[5 * 33]); o.w = pk2(s[6 * 33], s[7 * 33]);
        *(u32x4*)(WT + (size_t)(dst_row_off + n0 + n) * K + k0 + 8 * c) = o; }
    __builtin_amdgcn_s_waitcnt(0xc07f); asm volatile("" ::: "memory");
}
__device__ __forceinline__ float wave_sum(float v) {
#pragma unroll
    for (int o = 1; o < 64; o <<= 1) v += __shfl_xor(v, o);
    return v;
}
__device__ __forceinline__ void prologue_phase(const Ptrs& P, float* scr, int gw, int NGW, int lane) {
    unsigned char* ws = P.ws;
    constexpr int I1 = 16 * 192, I2 = 32 * 32, I3 = 16 * 176, I4 = 44 * 32, I5 = 16 * 32, I6 = 16 * 32;
    constexpr int NITEMS = I1 + I2 + I3 + I4 + 3 * I5 + I6 + I3 + I4;
    for (int it = gw; it < NITEMS; it += NGW) {
        int r = it;
        if (r < I1) { transpose_item(P.a_w_in, 1024, RIN, (bf16_t*)(ws + WS_W1), 0, P.a_norm_g, MAP_WIN, 0, RIN, scr, r, lane); continue; } r -= I1;
        if (r < I2) { transpose_item(P.a_w_o, 2048, 1024, (bf16_t*)(ws + WS_W2), 0, P.a_gn_g, MAP_ID, 0, 1024, scr, r, lane); continue; } r -= I2;
        if (r < I3) { transpose_item(P.a_w_gu, 1024, 2 * FF, (bf16_t*)(ws + WS_W3), 0, P.a_ffn_norm_g, MAP_GU, 0, 2 * FF, scr, r, lane); continue; } r -= I3;
        if (r < I4) { transpose_item(P.a_w_down, FF, 1024, (bf16_t*)(ws + WS_W4), 0, nullptr, MAP_ID, 0, 1024, scr, r, lane); continue; } r -= I4;
        if (r < I5) { transpose_item(P.w_kv, 1024, 2048, (bf16_t*)(ws + WS_W5), 0, P.kv_norm_g, MAP_HEAD, 0, 1024, scr, r, lane); continue; } r -= I5;
        if (r < I5) { transpose_item(P.w_kv, 1024, 2048, (bf16_t*)(ws + WS_W5), 1024, P.kv_norm_g, MAP_ID, 1024, 1024, scr, r, lane); continue; } r -= I5;
        if (r < I5) { transpose_item(P.b_w_q, 1024, 1024, (bf16_t*)(ws + WS_W5), 2048, P.b_norm_g, MAP_HEAD, 0, 1024, scr, r, lane); continue; } r -= I5;
        if (r < I6) { transpose_item(P.b_w_o, 1024, 1024, (bf16_t*)(ws + WS_W6), 0, nullptr, MAP_ID, 0, 1024, scr, r, lane); continue; } r -= I6;
        if (r < I3) { transpose_item(P.b_w_gu, 1024, 2 * FF, (bf16_t*)(ws + WS_W7), 0, P.b_ffn_norm_g, MAP_GU, 0, 2 * FF, scr, r, lane); continue; } r -= I3;
        transpose_item(P.b_w_down, FF, 1024, (bf16_t*)(ws + WS_W8), 0, nullptr, MAP_ID, 0, 1024, scr, r, lane);
    }
    bf16_t* xh0 = (bf16_t*)P.out; float* ss0 = (float*)(ws + WS_SS0);
    for (int m = gw; m < MTOK; m += NGW) {
        const f32x4* xr = (const f32x4*)(P.x + (size_t)m * DM) + lane; float s = 0.f; f32x4 v[4];
#pragma unroll
        for (int j = 0; j < 4; ++j) { v[j] = xr[64 * j]; s += (v[j][0] * v[j][0] + v[j][1] * v[j][1]) + (v[j][2] * v[j][2] + v[j][3] * v[j][3]); }
        s = wave_sum(s);
        u32x2* o = (u32x2*)(xh0 + (size_t)m * DM) + lane;
#pragma unroll
        for (int j = 0; j < 4; ++j) { u32x2 w; w.x = pk2(v[j][0], v[j][1]); w.y = pk2(v[j][2], v[j][3]); o[64 * j] = w; }
        if (lane == 0) ss0[m] = s;
    }
    float* rc = (float*)(ws + WS_COS); float* rsn = (float*)(ws + WS_SIN);
    for (int e = gw * 64 + lane; e < 128 * 32; e += NGW * 64) {
        const int i = e & 127, pb = e >> 7;
        double th = 1.0; { double b = 0.9305720409296989792906463164991; int k = i; while (k) { if (k & 1) th *= b; b *= b; k >>= 1; } }
        double c1, s1; { const double t2 = th * th; double cs = 1.0, sn = th, tc = 1.0, ts = th;
            for (int k = 1; k <= 12; ++k) { tc *= -t2 / ((2 * k - 1) * (2 * k)); ts *= -t2 / ((2 * k) * (2 * k + 1)); cs += tc; sn += ts; } c1 = cs; s1 = sn; }
        double c128 = c1, s128 = s1;
        for (int k = 0; k < 7; ++k) { const double c2 = c128 * c128 - s128 * s128, s2 = 2.0 * c128 * s128; c128 = c2; s128 = s2; }
        double cb = 1.0, sb = 0.0; { double bc = c128, bs = s128; int k = pb; while (k) { if (k & 1) { const double nc = cb * bc - sb * bs, ns = cb * bs + sb * bc; cb = nc; sb = ns; }
            const double c2 = bc * bc - bs * bs, s2 = 2.0 * bc * bs; bc = c2; bs = s2; k >>= 1; } }
        double cc = cb, sc = sb;
        for (int p = 0; p < 128; ++p) { const int pos = pb * 128 + p; rc[pos * 128 + i] = (float)cc; rsn[pos * 128 + i] = (float)sc;
            const double nc = cc * c1 - sc * s1, ns = cc * s1 + sc * c1; cc = nc; sc = ns; }
    }
}
__global__ void __launch_bounds__(256) nk_prologue(Ptrs P) {
    __shared__ float scr_all[4 * 64 * 33];
    const int wave = threadIdx.x >> 6, lane = threadIdx.x & 63;
    prologue_phase(P, scr_all + wave * 64 * 33, blockIdx.x * 4 + wave, gridDim.x * 4, lane);
}

struct EpiIn {
    static constexpr bool PERM = true, AFTER_DRAIN = false;
    const float* ss; const float* rcos; const float* rsin; bf16_t *Q, *K, *V, *G;
    __device__ __forceinline__ void frag(int row, int pn, int wc, int fq, const f32x4 (&v)[2][2]) const {
        const float rs = rstd_of(ss[row], 1.f / 1024.f);
        const int c8 = wc * 32 + fq * 8;
        const f32x4 a0 = v[0][0] * rs, a1 = v[0][1] * rs, b0 = v[1][0] * rs, b1 = v[1][1] * rs;
        if (pn < 8) {
            const int pos = row & (SEQ - 1);
            const f32x4 c0 = *(const f32x4*)(rcos + pos * 128 + c8), c1 = *(const f32x4*)(rcos + pos * 128 + c8 + 4);
            const f32x4 s0 = *(const f32x4*)(rsin + pos * 128 + c8), s1 = *(const f32x4*)(rsin + pos * 128 + c8 + 4);
            bf16_t* dst = (pn < 4 ? Q : K) + (size_t)row * 1024 + (pn & 3) * 256 + c8;
            store8bf(dst, a0 * c0 - b0 * s0, a1 * c1 - b1 * s1);
            store8bf(dst + 128, a0 * s0 + b0 * c0, a1 * s1 + b1 * c1);
        } else if (pn < 16) {
            bf16_t* dst = V + (size_t)row * 2048 + (pn - 8) * 256 + c8;
            store8bf(dst, a0, a1); store8bf(dst + 128, b0, b1);
        } else {
            bf16_t* dst = G + (size_t)row * 2048 + (pn - 16) * 256 + c8;
            f32x4 g[4] = {a0, a1, b0, b1};
#pragma unroll
            for (int i = 0; i < 4; ++i)
#pragma unroll
                for (int e = 0; e < 4; ++e) g[i][e] = g[i][e] / (1.f + __expf(-g[i][e]));
            store8bf(dst, g[0], g[1]); store8bf(dst + 128, g[2], g[3]);
        }
    }
};
struct EpiRes {
    static constexpr bool PERM = false, AFTER_DRAIN = false;
    const float* base; float* out; bf16_t* xh; float* ss;
    __device__ __forceinline__ void frag(int row, int pn, int wc, int fq, const f32x4 (&v)[2][2]) const {
        const size_t off0 = (size_t)row * DM + pn * 256 + wc * 32 + 4 * fq; float part = 0.f;
#pragma unroll
        for (int bj = 0; bj < 2; ++bj)
#pragma unroll
            for (int n = 0; n < 2; ++n) { const size_t off = off0 + bj * 128 + n * 16; const f32x4 x = *(const f32x4*)(base + off) + v[bj][n];
                *(f32x4*)(out + off) = x;
                if (xh) { u32x2 w; w.x = pk2(x[0], x[1]); w.y = pk2(x[2], x[3]); *(u32x2*)(xh + off) = w; }
                part += (x[0] * x[0] + x[1] * x[1]) + (x[2] * x[2] + x[3] * x[3]); }
        if (ss) { part += __shfl_xor(part, 16); part += __shfl_xor(part, 32); if (fq == 0) atomicAdd(ss + row, part); }
    }
};
struct EpiGU {
    static constexpr bool PERM = true, AFTER_DRAIN = false;
    const float* ss; bf16_t* H;
    __device__ __forceinline__ void frag(int row, int pn, int wc, int fq, const f32x4 (&v)[2][2]) const {
        const float rs = rstd_of(ss[row], 1.f / 1024.f);
        f32x4 h[2];
#pragma unroll
        for (int n = 0; n < 2; ++n)
#pragma unroll
            for (int e = 0; e < 4; ++e) { const float g = v[0][n][e] * rs, u = v[1][n][e] * rs; h[n][e] = g / (1.f + __expf(-g)) * u; }
        store8bf(H + (size_t)row * FF + pn * 128 + wc * 32 + fq * 8, h[0], h[1]);
    }
};
struct EpiKVQ {
    static constexpr bool PERM = true, AFTER_DRAIN = false;
    const float* ss; const float* kg; const float* qg; bf16_t *K2, *V2, *Q2;
    __device__ __forceinline__ void frag(int row, int pn, int wc, int fq, const f32x4 (&v)[2][2]) const {
        const float rs = rstd_of(ss[row], 1.f / 1024.f);
        const int t = pn >> 2, pl = pn & 3;
        f32x4 x[2][2]; float s = 0.f;
#pragma unroll
        for (int bj = 0; bj < 2; ++bj)
#pragma unroll
            for (int n = 0; n < 2; ++n) { x[bj][n] = v[bj][n] * rs; s += (x[bj][n][0] * x[bj][n][0] + x[bj][n][1] * x[bj][n][1]) + (x[bj][n][2] * x[bj][n][2] + x[bj][n][3] * x[bj][n][3]); }
        if (t == 1) {
            bf16_t* dst = V2 + (size_t)row * 1024 + pl * 256 + wc * 32 + fq * 8;
            store8bf(dst, x[0][0], x[0][1]); store8bf(dst + 128, x[1][0], x[1][1]);
        } else {
            s += __shfl_xor(s, 16); s += __shfl_xor(s, 32);
            const float rh = rstd_of(s, 1.f / 64.f) * (t == 2 ? 0.125f * LOG2E : 1.f);
            const float* gp = (t == 0 ? kg : qg) + fq * 8;
            bf16_t* dst = (t == 0 ? K2 : Q2) + (size_t)row * 1024 + (4 * pl + wc) * 64 + fq * 8;
#pragma unroll
            for (int bj = 0; bj < 2; ++bj) { const f32x4 g0 = *(const f32x4*)(gp + 32 * bj), g1 = *(const f32x4*)(gp + 32 * bj + 4);
                store8bf(dst + 32 * bj, x[bj][0] * g0 * rh, x[bj][1] * g1 * rh); }
        }
    }
};

template <class Epi> __global__ void __launch_bounds__(256) nk_gemm(const bf16_t* A, const bf16_t* Bt, int K, Epi E) {
    const int wc = threadIdx.x >> 6, lane = threadIdx.x & 63, fr = lane & 15, fq = lane >> 4;
    const int pn = blockIdx.x, row = blockIdx.y * 16 + fr;
    float acc[2][2][4];
    const bf16_t* bp[2][2];
#pragma unroll
    for (int bj = 0; bj < 2; ++bj)
#pragma unroll
        for (int n = 0; n < 2; ++n) { const int lc = bj * 128 + wc * 32 + (Epi::PERM ? 8 * fq + 4 * n : 16 * n + 4 * fq); bp[bj][n] = Bt + (size_t)(pn * 256 + lc) * K;
#pragma unroll
            for (int e = 0; e < 4; ++e) acc[bj][n][e] = 0.f; }
    const bf16_t* a = A + (size_t)row * K;
    for (int k = 0; k < K; k += 8) {
        const u32x4 av = *(const u32x4*)(a + k);
        const float af[8] = {bflo(av.x), bfhi(av.x), bflo(av.y), bfhi(av.y), bflo(av.z), bfhi(av.z), bflo(av.w), bfhi(av.w)};
#pragma unroll
        for (int bj = 0; bj < 2; ++bj)
#pragma unroll
            for (int n = 0; n < 2; ++n)
#pragma unroll
                for (int e = 0; e < 4; ++e) { const u32x4 bv = *(const u32x4*)(bp[bj][n] + (size_t)e * K + k);
                    float s = acc[bj][n][e];
                    s += af[0] * bflo(bv.x); s += af[1] * bfhi(bv.x); s += af[2] * bflo(bv.y); s += af[3] * bfhi(bv.y);
                    s += af[4] * bflo(bv.z); s += af[5] * bfhi(bv.z); s += af[6] * bflo(bv.w); s += af[7] * bfhi(bv.w); acc[bj][n][e] = s; }
    }
    f32x4 v[2][2];
#pragma unroll
    for (int bj = 0; bj < 2; ++bj)
#pragma unroll
        for (int n = 0; n < 2; ++n) v[bj][n] = (f32x4){acc[bj][n][0], acc[bj][n][1], acc[bj][n][2], acc[bj][n][3]};
    E.frag(row, pn, wc, fq, v);
}

constexpr int NR_QP = 264;
constexpr int NR_LDS = 2 * 64 * NR_QP * 2 + 64 * 32 * 4 + 64 * 65 * 4 + 256 * 33 * 4;
__global__ void __launch_bounds__(256) nk_retention(const bf16_t* Q, const bf16_t* Kc, bf16_t* VO, float* ssh) {
    extern __shared__ __attribute__((aligned(16))) unsigned char nr_lds[];
    bf16_t* qs = (bf16_t*)nr_lds; bf16_t* ks = qs + 64 * NR_QP; float* vs = (float*)(ks + 64 * NR_QP); float* Pm = vs + 64 * 32; float* S = Pm + 64 * 65;
    const int t = threadIdx.x, sl = blockIdx.x & 15, h = (blockIdx.x >> 4) & 3, b = blockIdx.x >> 6;
    const float l2g = log2f(1.0f - exp2f(-5.0f - (float)h));
    for (int i = t; i < 256 * 33; i += 256) S[i] = 0.f;
    const float sdec = exp2f(l2g * 64.f);
    for (int c = 0; c < NCH; ++c) {
        const size_t row0 = (size_t)b * SEQ + (size_t)c * CH;
        __syncthreads();
#pragma unroll
        for (int i = 0; i < 8; ++i) { const int p = t + 256 * i, r = p >> 5, cc = (p & 31) * 8;
            *(u32x4*)(qs + r * NR_QP + cc) = *(const u32x4*)(Q + (row0 + r) * 1024 + h * 256 + cc);
            *(u32x4*)(ks + r * NR_QP + cc) = *(const u32x4*)(Kc + (row0 + r) * 1024 + h * 256 + cc); }
        { const int r = t >> 2, cc = (t & 3) * 8; const u32x4 w = *(const u32x4*)(VO + (row0 + r) * 2048 + h * 512 + sl * 32 + cc);
          float* d = vs + r * 32 + cc; d[0] = bflo(w.x); d[1] = bfhi(w.x); d[2] = bflo(w.y); d[3] = bfhi(w.y); d[4] = bflo(w.z); d[5] = bfhi(w.z); d[6] = bflo(w.w); d[7] = bfhi(w.w); }
        __syncthreads();
        { const int ti = t >> 2, s0 = (t & 3) * 16; float acc[16];
#pragma unroll
          for (int j = 0; j < 16; ++j) acc[j] = 0.f;
          for (int k = 0; k < 256; k += 8) { const u32x4 qa = *(const u32x4*)(qs + ti * NR_QP + k);
              const float qf[8] = {bflo(qa.x), bfhi(qa.x), bflo(qa.y), bfhi(qa.y), bflo(qa.z), bfhi(qa.z), bflo(qa.w), bfhi(qa.w)};
#pragma unroll
              for (int j = 0; j < 16; ++j) { const u32x4 kb = *(const u32x4*)(ks + (s0 + j) * NR_QP + k);
                  acc[j] += qf[0] * bflo(kb.x) + qf[1] * bfhi(kb.x) + qf[2] * bflo(kb.y) + qf[3] * bfhi(kb.y) + qf[4] * bflo(kb.z) + qf[5] * bfhi(kb.z) + qf[6] * bflo(kb.w) + qf[7] * bfhi(kb.w); } }
#pragma unroll
          for (int j = 0; j < 16; ++j) { const int d = ti - (s0 + j); Pm[ti * 65 + s0 + j] = acc[j] * exp2f(l2g * (float)(d < 0 ? -d : d)); } }
        __syncthreads();
        { const int ti = t >> 2, v0 = (t & 3) * 8; float o[8];
#pragma unroll
          for (int j = 0; j < 8; ++j) o[j] = 0.f;
          for (int k = 0; k < 256; ++k) { const float qv = bf2f(qs[ti * NR_QP + k]);
#pragma unroll
              for (int j = 0; j < 8; ++j) o[j] += qv * S[k * 33 + v0 + j]; }
          const float qd = exp2f(l2g * (float)(ti + 1));
#pragma unroll
          for (int j = 0; j < 8; ++j) o[j] *= qd;
          for (int s = 0; s < 64; ++s) { const float p = Pm[ti * 65 + s];
#pragma unroll
              for (int j = 0; j < 8; ++j) o[j] += p * vs[s * 32 + v0 + j]; }
          float part = 0.f;
#pragma unroll
          for (int j = 0; j < 8; ++j) part += o[j] * o[j];
          part += __shfl_xor(part, 1); part += __shfl_xor(part, 2);
          if ((t & 3) == 0) atomicAdd(ssh + (row0 + ti) * 4 + h, part);
          u32x4 w; w.x = pk2(o[0], o[1]); w.y = pk2(o[2], o[3]); w.z = pk2(o[4], o[5]); w.w = pk2(o[6], o[7]);
          *(u32x4*)(VO + (row0 + ti) * 2048 + h * 512 + sl * 32 + v0) = w; }
        __syncthreads();
        { float kk[64];
#pragma unroll
          for (int s = 0; s < 64; ++s) kk[s] = bf2f(ks[s * NR_QP + t]) * exp2f(l2g * (float)(63 - s));
          for (int vv = 0; vv < 32; ++vv) { float a = S[t * 33 + vv] * sdec;
#pragma unroll
              for (int s = 0; s < 64; ++s) a += kk[s] * vs[s * 32 + vv];
              S[t * 33 + vv] = a; } }
    }
}
__global__ void __launch_bounds__(256) nk_retnorm(bf16_t* GY, const bf16_t* O, const float* ssh) {
    const size_t i = ((size_t)blockIdx.x * 256 + threadIdx.x) * 8;
    const size_t m = i >> 11; const int h = (int)((i & 2047) >> 9);
    const float r = rstd_of(ssh[m * 4 + h], 1.f / 512.f);
    const u32x4 g = *(const u32x4*)(GY + i), o = *(const u32x4*)(O + i); u32x4 w;
    w.x = pk2(bflo(g.x) * bflo(o.x) * r, bfhi(g.x) * bfhi(o.x) * r); w.y = pk2(bflo(g.y) * bflo(o.y) * r, bfhi(g.y) * bfhi(o.y) * r);
    w.z = pk2(bflo(g.z) * bflo(o.z) * r, bfhi(g.z) * bfhi(o.z) * r); w.w = pk2(bflo(g.w) * bflo(o.w) * r, bfhi(g.w) * bfhi(o.w) * r);
    *(u32x4*)(GY + i) = w;
}
__global__ void __launch_bounds__(64) nk_attention(const bf16_t* Q2, const bf16_t* K2, const bf16_t* V2, const float* rel_bias, bf16_t* O2) {
    __shared__ float kt[64 * 64], vt[64 * 64], bias[RELT];
    const int lane = threadIdx.x, ci = blockIdx.x & 63, h = (blockIdx.x >> 6) & 15, b = blockIdx.x >> 10;
    for (int i = lane; i < RELT; i += 64) bias[i] = rel_bias[h * RELT + i] * LOG2E;
    const size_t qrow = (size_t)b * SEQ + ci * 64 + lane;
    float q[64], o[64];
#pragma unroll
    for (int d = 0; d < 64; d += 8) { const u32x4 w = *(const u32x4*)(Q2 + qrow * 1024 + h * 64 + d);
        q[d] = bflo(w.x); q[d + 1] = bfhi(w.x); q[d + 2] = bflo(w.y); q[d + 3] = bfhi(w.y); q[d + 4] = bflo(w.z); q[d + 5] = bfhi(w.z); q[d + 6] = bflo(w.w); q[d + 7] = bfhi(w.w); }
#pragma unroll
    for (int d = 0; d < 64; ++d) o[d] = 0.f;
    float mx = -1e30f, l = 0.f;
    for (int kc = (ci - PAST < 0 ? 0 : ci - PAST); kc <= ci; ++kc) {
        __syncthreads();
        { const size_t krow = (size_t)b * SEQ + kc * 64 + lane;
#pragma unroll
          for (int d = 0; d < 64; d += 8) { const u32x4 w = *(const u32x4*)(K2 + krow * 1024 + h * 64 + d); float* p = kt + lane * 64 + d;
              p[0] = bflo(w.x); p[1] = bfhi(w.x); p[2] = bflo(w.y); p[3] = bfhi(w.y); p[4] = bflo(w.z); p[5] = bfhi(w.z); p[6] = bflo(w.w); p[7] = bfhi(w.w);
              const u32x4 u = *(const u32x4*)(V2 + krow * 1024 + h * 64 + d); float* r = vt + lane * 64 + d;
              r[0] = bflo(u.x); r[1] = bfhi(u.x); r[2] = bflo(u.y); r[3] = bfhi(u.y); r[4] = bflo(u.z); r[5] = bfhi(u.z); r[6] = bflo(u.w); r[7] = bfhi(u.w); } }
        __syncthreads();
        for (int j = 0; j < 64; ++j) {
            float s = 0.f;
#pragma unroll
            for (int d = 0; d < 64; ++d) s += q[d] * kt[j * 64 + d];
            int dist = (ci * 64 + lane) - (kc * 64 + j); dist = dist < -RELCLIP ? -RELCLIP : (dist > RELCLIP ? RELCLIP : dist);
            s += bias[dist + RELCLIP];
            const float mn = fmaxf(mx, s), f = exp2f(mx - mn), p = exp2f(s - mn);
            l = l * f + p; mx = mn;
#pragma unroll
            for (int d = 0; d < 64; ++d) o[d] = o[d] * f + p * vt[j * 64 + d];
        }
    }
    const float il = 1.f / l;
#pragma unroll
    for (int d = 0; d < 64; d += 8) { u32x4 w; w.x = pk2(o[d] * il, o[d + 1] * il); w.y = pk2(o[d + 2] * il, o[d + 3] * il); w.z = pk2(o[d + 4] * il, o[d + 5] * il); w.w = pk2(o[d + 6] * il, o[d + 7] * il);
        *(u32x4*)(O2 + qrow * 1024 + h * 64 + d) = w; }
}

extern "C" void kernel_launch(void* const* d_in, const int* in_sizes, int n_in, void* d_out, int out_size, void* d_ws, size_t ws_size, hipStream_t stream) {
    if (n_in != 19 || ws_size < WS_END || out_size != MTOK * DM) { fprintf(stderr, "kernel_launch: unexpected shapes (n_in %d, ws %zu, out %d)\n", n_in, ws_size, out_size); return; }
    Ptrs P{};
    const float** pp = (const float**)&P;
    for (int i = 0; i < 19; ++i) pp[i] = (const float*)d_in[i];
    P.out = (float*)d_out; P.ws = (unsigned char*)d_ws;
    unsigned char* ws = P.ws;
    static bool attr = false;
    if (!attr) { (void)hipFuncSetAttribute((const void*)nk_retention, hipFuncAttributeMaxDynamicSharedMemorySize, NR_LDS); attr = true; }
    (void)hipMemsetAsync(ws, 0, ZERO_BYTES, stream);
    float* ss0 = (float*)(ws + WS_SS0); float* ss1 = (float*)(ws + WS_SS1); float* ss2 = (float*)(ws + WS_SS2); float* ss3 = (float*)(ws + WS_SS3); float* ssh = (float*)(ws + WS_SSH);
    const float* rc = (const float*)(ws + WS_COS); const float* rsn = (const float*)(ws + WS_SIN);
    bf16_t* XH0 = (bf16_t*)d_out;
#define BF(off) ((bf16_t*)(ws + (off)))
    nk_prologue<<<1024, 256, 0, stream>>>(P);
    { EpiIn E{ss0, rc, rsn, BF(WS_Q), BF(WS_K), BF(WS_V), BF(WS_G)}; nk_gemm<EpiIn><<<dim3(RIN / 256, MTOK / 16), 256, 0, stream>>>(XH0, BF(WS_W1), 1024, E); }
    nk_retention<<<BATCH * RH * 16, 256, NR_LDS, stream>>>(BF(WS_Q), BF(WS_K), BF(WS_V), ssh);
    nk_retnorm<<<MTOK * 2048 / 8 / 256, 256, 0, stream>>>(BF(WS_G), BF(WS_V), ssh);
    { EpiRes E{P.x, P.out, BF(WS_XH1), ss1}; nk_gemm<EpiRes><<<dim3(4, MTOK / 16), 256, 0, stream>>>(BF(WS_G), BF(WS_W2), 2048, E); }
    { EpiGU E{ss1, BF(WS_H)}; nk_gemm<EpiGU><<<dim3(2 * FF / 256, MTOK / 16), 256, 0, stream>>>(BF(WS_XH1), BF(WS_W3), 1024, E); }
    { EpiRes E{P.out, P.out, BF(WS_XH2), ss2}; nk_gemm<EpiRes><<<dim3(4, MTOK / 16), 256, 0, stream>>>(BF(WS_H), BF(WS_W4), FF, E); }
    { EpiKVQ E{ss2, P.k_norm_g, P.b_q_norm_g, BF(WS_K2), BF(WS_V2), BF(WS_Q2)}; nk_gemm<EpiKVQ><<<dim3(12, MTOK / 16), 256, 0, stream>>>(BF(WS_XH2), BF(WS_W5), 1024, E); }
    nk_attention<<<BATCH * AH * NCH, 64, 0, stream>>>(BF(WS_Q2), BF(WS_K2), BF(WS_V2), P.b_rel_bias, BF(WS_O2));
    { EpiRes E{P.out, P.out, BF(WS_XH3), ss3}; nk_gemm<EpiRes><<<dim3(4, MTOK / 16), 256, 0, stream>>>(BF(WS_O2), BF(WS_W6), 1024, E); }
    { EpiGU E{ss3, BF(WS_H)}; nk_gemm<EpiGU><<<dim3(2 * FF / 256, MTOK / 16), 256, 0, stream>>>(BF(WS_XH3), BF(WS_W7), 1024, E); }
    { EpiRes E{P.out, P.out, nullptr, nullptr}; nk_gemm<EpiRes><<<dim3(4, MTOK / 16), 256, 0, stream>>>(BF(WS_H), BF(WS_W8), FF, E); }
#undef BF
}
```

```cpp
#include <hip/hip_runtime.h>
#include <cstdio>
#include <cstdint>

typedef unsigned short bf16_t;
typedef short bf16x8 __attribute__((ext_vector_type(8)));
typedef float f32x4 __attribute__((ext_vector_type(4)));
typedef float f32x2 __attribute__((ext_vector_type(2)));
typedef unsigned u32x4 __attribute__((ext_vector_type(4)));
typedef unsigned u32x2 __attribute__((ext_vector_type(2)));

constexpr int BATCH = 8, SEQ = 4096, DM = 1024, MTOK = BATCH * SEQ;
constexpr int CH = 64, NCH = SEQ / CH;
constexpr int RH = 4, RDK = 256, RDV = 512, RQC = 1024, RVC = 2048, RIN = 6144;
constexpr int AH = 16, AHD = 64, PAST = 8, RELCLIP = 256, RELT = 513;
constexpr int FF = 2816;
constexpr float EPS = 1e-6f;
constexpr float LOG2E = 1.4426950408889634f;

constexpr size_t MiB = 1u << 20;
constexpr size_t WS_CTL = 0;
constexpr size_t WS_SS1 = 1 * MiB;
constexpr size_t WS_SS2 = WS_SS1 + 128 * 1024;
constexpr size_t WS_SS3 = WS_SS2 + 128 * 1024;
constexpr size_t WS_SSH = WS_SS1 + 512 * 1024;
constexpr size_t ZERO_BYTES = 2 * MiB;
constexpr size_t WS_SS0 = 2 * MiB;
constexpr size_t WS_COS = 3 * MiB, WS_SIN = 5 * MiB;
constexpr size_t WS_W1 = 8 * MiB, WS_W2 = 20 * MiB, WS_W3 = 24 * MiB, WS_W4 = 35 * MiB, WS_W5 = 41 * MiB, WS_W6 = 47 * MiB, WS_W7 = 49 * MiB, WS_W8 = 60 * MiB;
constexpr size_t WS_Q = 72 * MiB, WS_K = 136 * MiB, WS_V = 200 * MiB, WS_G = 328 * MiB;
constexpr size_t WS_XH1 = 248 * MiB, WS_H = 72 * MiB, WS_XH2 = 328 * MiB;
constexpr size_t WS_K2 = 72 * MiB, WS_V2 = 136 * MiB, WS_Q2 = 200 * MiB, WS_O2 = 264 * MiB, WS_XH3 = 392 * MiB;
constexpr size_t WS_END = 456 * MiB;

struct Ptrs {
    const float *x, *a_norm_g, *a_w_in, *a_gn_g, *a_w_o, *a_ffn_norm_g, *a_w_gu, *a_w_down, *kv_norm_g, *w_kv, *k_norm_g,
                *b_norm_g, *b_w_q, *b_q_norm_g, *b_rel_bias, *b_w_o, *b_ffn_norm_g, *b_w_gu, *b_w_down;
    float* out; unsigned char* ws;
};

__device__ __forceinline__ unsigned f2bf(float f) { unsigned u = __float_as_uint(f); return (u + 0x7fffu + ((u >> 16) & 1u)) >> 16; }
__device__ __forceinline__ unsigned pk2(float lo, float hi) { return f2bf(lo) | (f2bf(hi) << 16); }
__device__ __forceinline__ float bf2f(unsigned short h) { return __uint_as_float((unsigned)h << 16); }
__device__ __forceinline__ float bflo(unsigned w) { return __uint_as_float(w << 16); }
__device__ __forceinline__ float bfhi(unsigned w) { return __uint_as_float(w & 0xffff0000u); }
__device__ __forceinline__ void store8bf(bf16_t* dst, const f32x4 a, const f32x4 b) {
    u32x4 w; w.x = pk2(a[0], a[1]); w.y = pk2(a[2], a[3]); w.z = pk2(b[0], b[1]); w.w = pk2(b[2], b[3]); *(u32x4*)dst = w;
}
__device__ __forceinline__ float rstd_of(float ss, float inv_n) { return 1.0f / sqrtf(ss * inv_n + EPS); }

enum { MAP_ID = 0, MAP_WIN = 1, MAP_GU = 2, MAP_HEAD = 3 };
__device__ __forceinline__ void transpose_item(const float* W, int K, int Nsrc, bf16_t* WT, int dst_row_off, const float* gain, int map, int src_off,
                                               int Ndst, float* scr, int item, int lane) {
    const int nblk = Ndst / 32, kb = item / nblk, nb = item % nblk, k0 = 64 * kb, n0 = 32 * nb;
    int src; float cs = 1.f;
    if (map == MAP_GU) { const int pn = n0 >> 8, c = n0 & 255; src = c < 128 ? 128 * pn + c : FF + 128 * pn + (c - 128); }
    else if (map == MAP_HEAD) { const int pn = n0 >> 8, c = n0 & 255, bj = c >> 7, wc = (c & 127) >> 5; src = src_off + 256 * pn + 64 * wc + 32 * bj; }
    else { src = src_off + n0; if (map == MAP_WIN && n0 >= 1024 && n0 < 2048) cs = 0.0625f; }
#pragma unroll 8
    for (int i = 0; i < 32; ++i) { const int kk = 2 * i + (lane >> 5); float g = gain ? gain[k0 + kk] : 1.f;
        scr[kk * 33 + (lane & 31)] = W[(size_t)(k0 + kk) * Nsrc + src + (lane & 31)] * (g * cs); }
    __builtin_amdgcn_s_waitcnt(0xc07f); asm volatile("" ::: "memory");
    const int c = lane & 7;
#pragma unroll
    for (int j = 0; j < 4; ++j) { const int n = (lane >> 3) + 8 * j; const float* s = scr + (8 * c) * 33 + n;
        u32x4 o; o.x = pk2(s[0 * 33], s[1 * 33]); o.y = pk2(s[2 * 33], s[3 * 33]); o.z = pk2(s[4 * 33], s[5 * 33]); o.w = pk2(s[6 * 33], s[7 * 33]);
        *(u32x4*)(WT + (size_t)(dst_row_off + n0 + n) * K + k0 + 8 * c) = o; }
    __builtin_amdgcn_s_waitcnt(0xc07f); asm volatile("" ::: "memory");
}
__device__ __forceinline__ float wave_sum(float v) {
#pragma unroll
    for (int o = 1; o < 64; o <<= 1) v += __shfl_xor(v, o);
    return v;
}
__device__ __forceinline__ void prologue_phase(const Ptrs& P, float* scr, int gw, int NGW, int lane) {
    unsigned char* ws = P.ws;
    constexpr int I1 = 16 * 192, I2 = 32 * 32, I3 = 16 * 176, I4 = 44 * 32, I5 = 16 * 32, I6 = 16 * 32;
    constexpr int NITEMS = I1 + I2 + I3 + I4 + 3 * I5 + I6 + I3 + I4;
    for (int it = gw; it < NITEMS; it += NGW) {
        int r = it;
        if (r < I1) { transpose_item(P.a_w_in, 1024, RIN, (bf16_t*)(ws + WS_W1), 0, P.a_norm_g, MAP_WIN, 0, RIN, scr, r, lane); continue; } r -= I1;
        if (r < I2) { transpose_item(P.a_w_o, 2048, 1024, (bf16_t*)(ws + WS_W2), 0, P.a_gn_g, MAP_ID, 0, 1024, scr, r, lane); continue; } r -= I2;
        if (r < I3) { transpose_item(P.a_w_gu, 1024, 2 * FF, (bf16_t*)(ws + WS_W3), 0, P.a_ffn_norm_g, MAP_GU, 0, 2 * FF, scr, r, lane); continue; } r -= I3;
        if (r < I4) { transpose_item(P.a_w_down, FF, 1024, (bf16_t*)(ws + WS_W4), 0, nullptr, MAP_ID, 0, 1024, scr, r, lane); continue; } r -= I4;
        if (r < I5) { transpose_item(P.w_kv, 1024, 2048, (bf16_t*)(ws + WS_W5), 0, P.kv_norm_g, MAP_HEAD, 0, 1024, scr, r, lane); continue; } r -= I5;
        if (r < I5) { transpose_item(P.w_kv, 1024, 2048, (bf16_t*)(ws + WS_W5), 1024, P.kv_norm_g, MAP_ID, 1024, 1024, scr, r, lane); continue; } r -= I5;
        if (r < I5) { transpose_item(P.b_w_q, 1024, 1024, (bf16_t*)(ws + WS_W5), 2048, P.b_norm_g, MAP_HEAD, 0, 1024, scr, r, lane); continue; } r -= I5;
        if (r < I6) { transpose_item(P.b_w_o, 1024, 1024, (bf16_t*)(ws + WS_W6), 0, nullptr, MAP_ID, 0, 1024, scr, r, lane); continue; } r -= I6;
        if (r < I3) { transpose_item(P.b_w_gu, 1024, 2 * FF, (bf16_t*)(ws + WS_W7), 0, P.b_ffn_norm_g, MAP_GU, 0, 2 * FF, scr, r, lane); continue; } r -= I3;
        transpose_item(P.b_w_down, FF, 1024, (bf16_t*)(ws + WS_W8), 0, nullptr, MAP_ID, 0, 1024, scr, r, lane);
    }
    bf16_t* xh0 = (bf16_t*)P.out; float* ss0 = (float*)(ws + WS_SS0);
    for (int m = gw; m < MTOK; m += NGW) {
        const f32x4* xr = (const f32x4*)(P.x + (size_t)m * DM) + lane; float s = 0.f; f32x4 v[4];
#pragma unroll
        for (int j = 0; j < 4; ++j) { v[j] = xr[64 * j]; s += (v[j][0] * v[j][0] + v[j][1] * v[j][1]) + (v[j][2] * v[j][2] + v[j][3] * v[j][3]); }
        s = wave_sum(s);
        u32x2* o = (u32x2*)(xh0 + (size_t)m * DM) + lane;
#pragma unroll
        for (int j = 0; j < 4; ++j) { u32x2 w; w.x = pk2(v[j][0], v[j][1]); w.y = pk2(v[j][2], v[j][3]); o[64 * j] = w; }
        if (lane == 0) ss0[m] = s;
    }
    float* rc = (float*)(ws + WS_COS); float* rsn = (float*)(ws + WS_SIN);
    for (int e = gw * 64 + lane; e < 128 * 32; e += NGW * 64) {
        const int i = e & 127, pb = e >> 7;
        double th = 1.0; { double b = 0.9305720409296989792906463164991; int k = i; while (k) { if (k & 1) th *= b; b *= b; k >>= 1; } }
        double c1, s1; { const double t2 = th * th; double cs = 1.0, sn = th, tc = 1.0, ts = th;
            for (int k = 1; k <= 12; ++k) { tc *= -t2 / ((2 * k - 1) * (2 * k)); ts *= -t2 / ((2 * k) * (2 * k + 1)); cs += tc; sn += ts; } c1 = cs; s1 = sn; }
        double c128 = c1, s128 = s1;
        for (int k = 0; k < 7; ++k) { const double c2 = c128 * c128 - s128 * s128, s2 = 2.0 * c128 * s128; c128 = c2; s128 = s2; }
        double cb = 1.0, sb = 0.0; { double bc = c128, bs = s128; int k = pb; while (k) { if (k & 1) { const double nc = cb * bc - sb * bs, ns = cb * bs + sb * bc; cb = nc; sb = ns; }
            const double c2 = bc * bc - bs * bs, s2 = 2.0 * bc * bs; bc = c2; bs = s2; k >>= 1; } }
        double cc = cb, sc = sb;
        for (int p = 0; p < 128; ++p) { const int pos = pb * 128 + p; rc[pos * 128 + i] = (float)cc; rsn[pos * 128 + i] = (float)sc;
            const double nc = cc * c1 - sc * s1, ns = cc * s1 + sc * c1; cc = nc; sc = ns; }
    }
}
__global__ void __launch_bounds__(256) nk_prologue(Ptrs P) {
    __shared__ float scr_all[4 * 64 * 33];
    const int wave = threadIdx.x >> 6, lane = threadIdx.x & 63;
    prologue_phase(P, scr_all + wave * 64 * 33, blockIdx.x * 4 + wave, gridDim.x * 4, lane);
}

__device__ __forceinline__ float ret_l2g(int h) { return log2f(1.0f - exp2f(-5.0f - (float)h)); }
__device__ __forceinline__ float ret_pfac(float l2g, int t, int s) { return exp2f(l2g * (float)(t >= s ? -64 : 2 * (s - t) - 64)); }

struct EpiIn {
    static constexpr bool PERM = true, AFTER_DRAIN = false;
    const float* ss; const float* rcos; const float* rsin; bf16_t *Q, *K, *V, *G;
    __device__ __forceinline__ void frag(int row, int pn, int wc, int fq, const f32x4 (&v)[2][2]) const {
        const float rs = rstd_of(ss[row], 1.f / 1024.f);
        const int c8 = wc * 32 + fq * 8;
        const f32x4 a0 = v[0][0] * rs, a1 = v[0][1] * rs, b0 = v[1][0] * rs, b1 = v[1][1] * rs;
        if (pn < 8) {
            const int pos = row & (SEQ - 1);
            const f32x4 c0 = *(const f32x4*)(rcos + pos * 128 + c8), c1 = *(const f32x4*)(rcos + pos * 128 + c8 + 4);
            const f32x4 s0 = *(const f32x4*)(rsin + pos * 128 + c8), s1 = *(const f32x4*)(rsin + pos * 128 + c8 + 4);
            bf16_t* dst = (pn < 4 ? Q : K) + (size_t)row * 1024 + (pn & 3) * 256 + c8;
            store8bf(dst, a0 * c0 - b0 * s0, a1 * c1 - b1 * s1);
            store8bf(dst + 128, a0 * s0 + b0 * c0, a1 * s1 + b1 * c1);
        } else if (pn < 16) {
            bf16_t* dst = V + (size_t)row * 2048 + (pn - 8) * 256 + c8;
            const float kd = exp2f(ret_l2g((pn - 8) >> 1) * (float)(63 - (row & 63)));
            store8bf(dst, a0 * kd, a1 * kd); store8bf(dst + 128, b0 * kd, b1 * kd);
        } else {
            bf16_t* dst = G + (size_t)row * 2048 + (pn - 16) * 256 + c8;
            f32x4 g[4] = {a0, a1, b0, b1};
#pragma unroll
            for (int i = 0; i < 4; ++i)
#pragma unroll
                for (int e = 0; e < 4; ++e) g[i][e] = g[i][e] / (1.f + __expf(-g[i][e]));
            store8bf(dst, g[0], g[1]); store8bf(dst + 128, g[2], g[3]);
        }
    }
};
struct EpiRes {
    static constexpr bool PERM = false, AFTER_DRAIN = false;
    const float* base; float* out; bf16_t* xh; float* ss;
    __device__ __forceinline__ void frag(int row, int pn, int wc, int fq, const f32x4 (&v)[2][2]) const {
        const size_t off0 = (size_t)row * DM + pn * 256 + wc * 32 + 4 * fq; float part = 0.f;
#pragma unroll
        for (int bj = 0; bj < 2; ++bj)
#pragma unroll
            for (int n = 0; n < 2; ++n) { const size_t off = off0 + bj * 128 + n * 16; const f32x4 x = *(const f32x4*)(base + off) + v[bj][n];
                *(f32x4*)(out + off) = x;
                if (xh) { u32x2 w; w.x = pk2(x[0], x[1]); w.y = pk2(x[2], x[3]); *(u32x2*)(xh + off) = w; }
                part += (x[0] * x[0] + x[1] * x[1]) + (x[2] * x[2] + x[3] * x[3]); }
        if (ss) { part += __shfl_xor(part, 16); part += __shfl_xor(part, 32); if (fq == 0) atomicAdd(ss + row, part); }
    }
};
struct EpiGU {
    static constexpr bool PERM = true, AFTER_DRAIN = false;
    const float* ss; bf16_t* H;
    __device__ __forceinline__ void frag(int row, int pn, int wc, int fq, const f32x4 (&v)[2][2]) const {
        const float rs = rstd_of(ss[row], 1.f / 1024.f);
        f32x4 h[2];
#pragma unroll
        for (int n = 0; n < 2; ++n)
#pragma unroll
            for (int e = 0; e < 4; ++e) { const float g = v[0][n][e] * rs, u = v[1][n][e] * rs; h[n][e] = g / (1.f + __expf(-g)) * u; }
        store8bf(H + (size_t)row * FF + pn * 128 + wc * 32 + fq * 8, h[0], h[1]);
    }
};
struct EpiKVQ {
    static constexpr bool PERM = true, AFTER_DRAIN = false;
    const float* ss; const float* kg; const float* qg; bf16_t *K2, *V2, *Q2;
    __device__ __forceinline__ void frag(int row, int pn, int wc, int fq, const f32x4 (&v)[2][2]) const {
        const float rs = rstd_of(ss[row], 1.f / 1024.f);
        const int t = pn >> 2, pl = pn & 3;
        f32x4 x[2][2]; float s = 0.f;
#pragma unroll
        for (int bj = 0; bj < 2; ++bj)
#pragma unroll
            for (int n = 0; n < 2; ++n) { x[bj][n] = v[bj][n] * rs; s += (x[bj][n][0] * x[bj][n][0] + x[bj][n][1] * x[bj][n][1]) + (x[bj][n][2] * x[bj][n][2] + x[bj][n][3] * x[bj][n][3]); }
        if (t == 1) {
            bf16_t* dst = V2 + (size_t)row * 1024 + pl * 256 + wc * 32 + fq * 8;
            store8bf(dst, x[0][0], x[0][1]); store8bf(dst + 128, x[1][0], x[1][1]);
        } else {
            s += __shfl_xor(s, 16); s += __shfl_xor(s, 32);
            const float rh = rstd_of(s, 1.f / 64.f) * (t == 2 ? 0.125f * LOG2E : 1.f);
            const float* gp = (t == 0 ? kg : qg) + fq * 8;
            bf16_t* dst = (t == 0 ? K2 : Q2) + (size_t)row * 1024 + (4 * pl + wc) * 64 + fq * 8;
#pragma unroll
            for (int bj = 0; bj < 2; ++bj) { const f32x4 g0 = *(const f32x4*)(gp + 32 * bj), g1 = *(const f32x4*)(gp + 32 * bj + 4);
                store8bf(dst + 32 * bj, x[bj][0] * g0 * rh, x[bj][1] * g1 * rh); }
        }
    }
};

template <class Epi> __global__ void __launch_bounds__(256) nk_gemm(const bf16_t* A, const bf16_t* Bt, int K, Epi E) {
    const int wc = threadIdx.x >> 6, lane = threadIdx.x & 63, fr = lane & 15, fq = lane >> 4;
    const int pn = blockIdx.x, row = blockIdx.y * 16 + fr;
    float acc[2][2][4];
    const bf16_t* bp[2][2];
#pragma unroll
    for (int bj = 0; bj < 2; ++bj)
#pragma unroll
        for (int n = 0; n < 2; ++n) { const int lc = bj * 128 + wc * 32 + (Epi::PERM ? 8 * fq + 4 * n : 16 * n + 4 * fq); bp[bj][n] = Bt + (size_t)(pn * 256 + lc) * K;
#pragma unroll
            for (int e = 0; e < 4; ++e) acc[bj][n][e] = 0.f; }
    const bf16_t* a = A + (size_t)row * K;
    for (int k = 0; k < K; k += 8) {
        const u32x4 av = *(const u32x4*)(a + k);
        const float af[8] = {bflo(av.x), bfhi(av.x), bflo(av.y), bfhi(av.y), bflo(av.z), bfhi(av.z), bflo(av.w), bfhi(av.w)};
#pragma unroll
        for (int bj = 0; bj < 2; ++bj)
#pragma unroll
            for (int n = 0; n < 2; ++n)
#pragma unroll
                for (int e = 0; e < 4; ++e) { const u32x4 bv = *(const u32x4*)(bp[bj][n] + (size_t)e * K + k);
                    float s = acc[bj][n][e];
                    s += af[0] * bflo(bv.x); s += af[1] * bfhi(bv.x); s += af[2] * bflo(bv.y); s += af[3] * bfhi(bv.y);
                    s += af[4] * bflo(bv.z); s += af[5] * bfhi(bv.z); s += af[6] * bflo(bv.w); s += af[7] * bfhi(bv.w); acc[bj][n][e] = s; }
    }
    f32x4 v[2][2];
#pragma unroll
    for (int bj = 0; bj < 2; ++bj)
#pragma unroll
        for (int n = 0; n < 2; ++n) v[bj][n] = (f32x4){acc[bj][n][0], acc[bj][n][1], acc[bj][n][2], acc[bj][n][3]};
    E.frag(row, pn, wc, fq, v);
}

constexpr int NR_QP = 264;
constexpr int NR_LDS = 2 * 64 * NR_QP * 2 + 64 * 32 * 4 + 64 * 65 * 4 + 256 * 33 * 4;
__global__ void __launch_bounds__(256) nk_retention(const bf16_t* Q, const bf16_t* Kc, bf16_t* VO, float* ssh) {
    extern __shared__ __attribute__((aligned(16))) unsigned char nr_lds[];
    bf16_t* qs = (bf16_t*)nr_lds; bf16_t* ks = qs + 64 * NR_QP; float* vs = (float*)(ks + 64 * NR_QP); float* Pm = vs + 64 * 32; float* S = Pm + 64 * 65;
    const int t = threadIdx.x, sl = blockIdx.x & 15, h = (blockIdx.x >> 4) & 3, b = blockIdx.x >> 6;
    const float l2g = ret_l2g(h);
    for (int i = t; i < 256 * 33; i += 256) S[i] = 0.f;
    const float sdec = exp2f(l2g * 64.f);
    for (int c = 0; c < NCH; ++c) {
        const size_t row0 = (size_t)b * SEQ + (size_t)c * CH;
        __syncthreads();
#pragma unroll
        for (int i = 0; i < 8; ++i) { const int p = t + 256 * i, r = p >> 5, cc = (p & 31) * 8;
            *(u32x4*)(qs + r * NR_QP + cc) = *(const u32x4*)(Q + (row0 + r) * 1024 + h * 256 + cc);
            *(u32x4*)(ks + r * NR_QP + cc) = *(const u32x4*)(Kc + (row0 + r) * 1024 + h * 256 + cc); }
        { const int r = t >> 2, cc = (t & 3) * 8; const u32x4 w = *(const u32x4*)(VO + (row0 + r) * 2048 + h * 512 + sl * 32 + cc);
          float* d = vs + r * 32 + cc; d[0] = bflo(w.x); d[1] = bfhi(w.x); d[2] = bflo(w.y); d[3] = bfhi(w.y); d[4] = bflo(w.z); d[5] = bfhi(w.z); d[6] = bflo(w.w); d[7] = bfhi(w.w); }
        __syncthreads();
        { const int ti = t >> 2, s0 = (t & 3) * 16; float acc[16];
#pragma unroll
          for (int j = 0; j < 16; ++j) acc[j] = 0.f;
          for (int k = 0; k < 256; k += 8) { const u32x4 qa = *(const u32x4*)(qs + ti * NR_QP + k);
              const float qf[8] = {bflo(qa.x), bfhi(qa.x), bflo(qa.y), bfhi(qa.y), bflo(qa.z), bfhi(qa.z), bflo(qa.w), bfhi(qa.w)};
#pragma unroll
              for (int j = 0; j < 16; ++j) { const u32x4 kb = *(const u32x4*)(ks + (s0 + j) * NR_QP + k);
                  acc[j] += qf[0] * bflo(kb.x) + qf[1] * bfhi(kb.x) + qf[2] * bflo(kb.y) + qf[3] * bfhi(kb.y) + qf[4] * bflo(kb.z) + qf[5] * bfhi(kb.z) + qf[6] * bflo(kb.w) + qf[7] * bfhi(kb.w); } }
#pragma unroll
          for (int j = 0; j < 16; ++j) Pm[ti * 65 + s0 + j] = acc[j] * ret_pfac(l2g, ti, s0 + j); }
        __syncthreads();
        { const int ti = t >> 2, v0 = (t & 3) * 8; float o[8];
#pragma unroll
          for (int j = 0; j < 8; ++j) o[j] = 0.f;
          for (int k = 0; k < 256; ++k) { const float qv = bf2f(qs[ti * NR_QP + k]);
#pragma unroll
              for (int j = 0; j < 8; ++j) o[j] += qv * S[k * 33 + v0 + j]; }
          const float qd = exp2f(l2g * (float)(ti + 1));
          for (int s = 0; s < 64; ++s) { const float p = Pm[ti * 65 + s];
#pragma unroll
              for (int j = 0; j < 8; ++j) o[j] += p * vs[s * 32 + v0 + j]; }
#pragma unroll
          for (int j = 0; j < 8; ++j) o[j] *= qd;
          float part = 0.f;
#pragma unroll
          for (int j = 0; j < 8; ++j) part += o[j] * o[j];
          part += __shfl_xor(part, 1); part += __shfl_xor(part, 2);
          if ((t & 3) == 0) atomicAdd(ssh + (row0 + ti) * 4 + h, part);
          u32x4 w; w.x = pk2(o[0], o[1]); w.y = pk2(o[2], o[3]); w.z = pk2(o[4], o[5]); w.w = pk2(o[6], o[7]);
          *(u32x4*)(VO + (row0 + ti) * 2048 + h * 512 + sl * 32 + v0) = w; }
        __syncthreads();
        { float kk[64];
#pragma unroll
          for (int s = 0; s < 64; ++s) kk[s] = bf2f(ks[s * NR_QP + t]);
          for (int vv = 0; vv < 32; ++vv) { float a = S[t * 33 + vv] * sdec;
#pragma unroll
              for (int s = 0; s < 64; ++s) a += kk[s] * vs[s * 32 + vv];
              S[t * 33 + vv] = a; } }
    }
}
__global__ void __launch_bounds__(256) nk_retnorm(bf16_t* GY, const bf16_t* O, const float* ssh) {
    const size_t i = ((size_t)blockIdx.x * 256 + threadIdx.x) * 8;
    const size_t m = i >> 11; const int h = (int)((i & 2047) >> 9);
    const float r = rstd_of(ssh[m * 4 + h], 1.f / 512.f);
    const u32x4 g = *(const u32x4*)(GY + i), o = *(const u32x4*)(O + i); u32x4 w;
    w.x = pk2(bflo(g.x) * bflo(o.x) * r, bfhi(g.x) * bfhi(o.x) * r); w.y = pk2(bflo(g.y) * bflo(o.y) * r, bfhi(g.y) * bfhi(o.y) * r);
    w.z = pk2(bflo(g.z) * bflo(o.z) * r, bfhi(g.z) * bfhi(o.z) * r); w.w = pk2(bflo(g.w) * bflo(o.w) * r, bfhi(g.w) * bfhi(o.w) * r);
    *(u32x4*)(GY + i) = w;
}
__global__ void __launch_bounds__(64) nk_attention(const bf16_t* Q2, const bf16_t* K2, const bf16_t* V2, const float* rel_bias, bf16_t* O2) {
    __shared__ float kt[64 * 64], vt[64 * 64], bias[RELT];
    const int lane = threadIdx.x, ci = blockIdx.x & 63, h = (blockIdx.x >> 6) & 15, b = blockIdx.x >> 10;
    for (int i = lane; i < RELT; i += 64) bias[i] = rel_bias[h * RELT + i] * LOG2E;
    const size_t qrow = (size_t)b * SEQ + ci * 64 + lane;
    float q[64], o[64];
#pragma unroll
    for (int d = 0; d < 64; d += 8) { const u32x4 w = *(const u32x4*)(Q2 + qrow * 1024 + h * 64 + d);
        q[d] = bflo(w.x); q[d + 1] = bfhi(w.x); q[d + 2] = bflo(w.y); q[d + 3] = bfhi(w.y); q[d + 4] = bflo(w.z); q[d + 5] = bfhi(w.z); q[d + 6] = bflo(w.w); q[d + 7] = bfhi(w.w); }
#pragma unroll
    for (int d = 0; d < 64; ++d) o[d] = 0.f;
    float mx = -1e30f, l = 0.f;
    for (int kc = (ci - PAST < 0 ? 0 : ci - PAST); kc <= ci; ++kc) {
        __syncthreads();
        { const size_t krow = (size_t)b * SEQ + kc * 64 + lane;
#pragma unroll
          for (int d = 0; d < 64; d += 8) { const u32x4 w = *(const u32x4*)(K2 + krow * 1024 + h * 64 + d); float* p = kt + lane * 64 + d;
              p[0] = bflo(w.x); p[1] = bfhi(w.x); p[2] = bflo(w.y); p[3] = bfhi(w.y); p[4] = bflo(w.z); p[5] = bfhi(w.z); p[6] = bflo(w.w); p[7] = bfhi(w.w);
              const u32x4 u = *(const u32x4*)(V2 + krow * 1024 + h * 64 + d); float* r = vt + lane * 64 + d;
              r[0] = bflo(u.x); r[1] = bfhi(u.x); r[2] = bflo(u.y); r[3] = bfhi(u.y); r[4] = bflo(u.z); r[5] = bfhi(u.z); r[6] = bflo(u.w); r[7] = bfhi(u.w); } }
        __syncthreads();
        for (int j = 0; j < 64; ++j) {
            float s = 0.f;
#pragma unroll
            for (int d = 0; d < 64; ++d) s += q[d] * kt[j * 64 + d];
            int dist = (ci * 64 + lane) - (kc * 64 + j); dist = dist < -RELCLIP ? -RELCLIP : (dist > RELCLIP ? RELCLIP : dist);
            s += bias[dist + RELCLIP];
            const float mn = fmaxf(mx, s), f = exp2f(mx - mn), p = exp2f(s - mn);
            l = l * f + p; mx = mn;
#pragma unroll
            for (int d = 0; d < 64; ++d) o[d] = o[d] * f + p * vt[j * 64 + d];
        }
    }
    const float il = 1.f / l;
#pragma unroll
    for (int d = 0; d < 64; d += 8) { u32x4 w; w.x = pk2(o[d] * il, o[d + 1] * il); w.y = pk2(o[d + 2] * il, o[d + 3] * il); w.z = pk2(o[d + 4] * il, o[d + 5] * il); w.w = pk2(o[d + 6] * il, o[d + 7] * il);
        *(u32x4*)(O2 + qrow * 1024 + h * 64 + d) = w; }
}

namespace pg8 {
#define PG8_LAS __attribute__((address_space(3)))
typedef unsigned short bf16_t;
typedef short bf16x8 __attribute__((ext_vector_type(8)));
typedef float f32x4 __attribute__((ext_vector_type(4)));
typedef unsigned u32x4 __attribute__((ext_vector_type(4)));
constexpr int BM = 256, BK = 64, HALF = 128, HTB = HALF * BK * 2  , STAGE_BYTES = 8 * HTB, NXCD = 8, WGM = 8;

__host__ __device__ __forceinline__ int lds_byte(int r, int c) { const int st = (r >> 4) * 2 + (c >> 5), rr = r & 15, cc = c & 31, ob = rr * 64 + cc * 2; return st * 1024 + (ob ^ (((ob >> 9) & 1) << 5)); }
__host__ __device__ __forceinline__ void stage_rc(int b, int& R, int& C) { const int st = b / 1024, sb = b % 1024, swz = sb ^ (((sb >> 9) & 1) << 5); R = (st >> 1) * 16 + swz / 64; C = (st & 1) * 32 + (swz % 64) / 2; }
__host__ __device__ __forceinline__ int perm32(int rho) { const int n = rho >> 4, i = rho & 15; return 8 * (i >> 2) + 4 * n + (i & 3); }

struct Unit { int pm, pn; };
struct Gemm { const bf16_t* A; const bf16_t* Bt; int M, N, K; };

struct StaticOrder {
    int nM, nN, nwg, G, c;
    __host__ __device__ void init(int M, int N, int G_, int c_) { nM = M / BM; nN = N / BM; nwg = nM * nN; G = G_; c = c_; }
    __host__ __device__ bool next(int i, Unit& u) const {
        const long L = (long)i * G + c; if (L >= nwg) return false;
        int wgid = (int)L; { const int q = nwg / NXCD, r = nwg % NXCD, xcd = wgid % NXCD, off = wgid / NXCD; wgid = (xcd < r ? xcd * (q + 1) : r * (q + 1) + (xcd - r) * q) + off; }
        const int nig = WGM * nN, gid = wgid / nig, fm = gid * WGM, gsz = (nM - fm) < WGM ? (nM - fm) : WGM;
        u.pm = fm + ((wgid % nig) % gsz); u.pn = (wgid % nig) / gsz; return true;
    }
    __device__ __forceinline__ void a_ready(const Unit&) const {}
    __device__ __forceinline__ void done(const Unit&) const {}
};
__device__ __forceinline__ unsigned cvt_pk_bf16(float lo, float hi) { unsigned r; asm volatile("v_cvt_pk_bf16_f32 %0, %1, %2" : "=v"(r) : "v"(lo), "v"(hi)); return r; }

template <class Epi> __device__ __forceinline__ void run_epi(const Epi& E, const f32x4 (&acc)[2][2][4][2], const Unit& u, int wr, int wc, int fr, int fq) {
#pragma unroll
    for (int ai = 0; ai < 2; ++ai)
#pragma unroll
        for (int m = 0; m < 4; ++m) {
            const f32x4 v[2][2] = {{acc[ai][0][m][0], acc[ai][0][m][1]}, {acc[ai][1][m][0], acc[ai][1][m][1]}};
            E.frag(u.pm * BM + ai * HALF + wr * 64 + m * 16 + fr, u.pn, wc, fq, v);
            asm volatile("" ::: "memory");
        }
}
template <class Epi, class Sched, bool ALIGN_EPI = false, bool SP2 = false>
__device__ __forceinline__ void gemm_phase(PG8_LAS unsigned char* lds, const Gemm g, const Sched& S, const Epi& E, const int tid) {
    const int wid = __builtin_amdgcn_readfirstlane(tid >> 6), lane = tid & 63, wr = wid >> 2, wc = wid & 3, fr = lane & 15, fq = lane >> 4;
    const int K = g.K, nt = K / BK;
    unsigned voffA[2], voffB[2];
#pragma unroll
    for (int i = 0; i < 2; ++i) { int R, C; stage_rc(tid * 16 + i * 8192, R, C); const int Rb = Epi::PERM ? ((R & ~31) + perm32(R & 31)) : R;
        voffA[i] = (unsigned)(R * K + C) * 2u; voffB[i] = (unsigned)(Rb * K + C) * 2u; }
    const size_t kstep = (size_t)(BK * 2);
    const size_t hstep = (size_t)HALF * K * 2;
    const size_t tstep = 2 * hstep;
    const unsigned ldsw = (unsigned)wid * 1024u;
    const int aoff = lds_byte(wr * 64 + fr, fq * 8), boff = lds_byte(wc * 32 + fr, fq * 8);
#define PG8_SA(b, h) (((b) * 2 + (h)) * HTB)
#define PG8_SB(b, h) ((4 + (b) * 2 + (h)) * HTB)
#define PG8_STAGE(bufoff, gbase, voff) do { _Pragma("unroll") for (int _i = 0; _i < 2; ++_i) \
        __builtin_amdgcn_global_load_lds((const unsigned*)((const char*)(gbase) + (voff)[_i]), (PG8_LAS unsigned*)(lds + (bufoff) + ldsw + _i * 8192), 16, 0, 0); } while (0)
#define PG8_LDA(dst, b, h) do { _Pragma("unroll") for (int m = 0; m < 4; ++m) _Pragma("unroll") for (int k = 0; k < 2; ++k) dst[m][k] = *(const PG8_LAS bf16x8*)(lds + PG8_SA(b, h) + aoff + m * 2048 + k * 1024); } while (0)
#define PG8_LDB(dst, b, h) do { _Pragma("unroll") for (int n = 0; n < 2; ++n) _Pragma("unroll") for (int k = 0; k < 2; ++k) dst[n][k] = *(const PG8_LAS bf16x8*)(lds + PG8_SB(b, h) + boff + n * 2048 + k * 1024); } while (0)
#define PG8_MMA(ai, bj, At, Bt) do { __builtin_amdgcn_s_setprio(1); _Pragma("unroll") for (int m = 0; m < 4; ++m) _Pragma("unroll") for (int n = 0; n < 2; ++n) _Pragma("unroll") for (int k = 0; k < 2; ++k) \
        acc[ai][bj][m][n] = __builtin_amdgcn_mfma_f32_16x16x32_bf16(Bt[n][k], At[m][k], acc[ai][bj][m][n], 0, 0, 0); __builtin_amdgcn_s_setprio(0); } while (0)
#define PG8_WAIT_V(n) asm volatile("s_waitcnt vmcnt(" #n ")" ::: "memory")
#define PG8_WAIT_L(n) asm volatile("s_waitcnt lgkmcnt(" #n ")" ::: "memory")
#define PG8_BAR __builtin_amdgcn_s_barrier()
#define PG8_SCHED __builtin_amdgcn_sched_barrier(0)
    Unit cur, nxt; int ui = 0;
    if (!S.next(0, cur)) return;
    f32x4 acc[2][2][4][2];
#pragma unroll
    for (int a = 0; a < 2; ++a)
#pragma unroll
        for (int b = 0; b < 2; ++b)
#pragma unroll
            for (int m = 0; m < 4; ++m)
#pragma unroll
                for (int n = 0; n < 2; ++n) acc[a][b][m][n] = (f32x4){0.f, 0.f, 0.f, 0.f};
    bf16x8 At[4][2], B0[2][2], B1[2][2];
    const char* cA = (const char*)g.A + (size_t)cur.pm * tstep; const char* cB = (const char*)g.Bt + (size_t)cur.pn * tstep;
    S.a_ready(cur);
    if constexpr (SP2) {
        PG8_STAGE(PG8_SB(0, 0), cB, voffB); PG8_STAGE(PG8_SB(0, 1), cB + hstep, voffB); PG8_STAGE(PG8_SA(0, 0), cA, voffA); PG8_STAGE(PG8_SA(0, 1), cA + hstep, voffA);
        if (wr == 1) PG8_BAR;
        PG8_WAIT_V(2); PG8_BAR;
        PG8_STAGE(PG8_SB(1, 0), cB + kstep, voffB); PG8_STAGE(PG8_SA(1, 0), cA + kstep, voffA); PG8_STAGE(PG8_SB(1, 1), cB + hstep + kstep, voffB);
        PG8_WAIT_V(6); PG8_BAR;
    } else {
        PG8_STAGE(PG8_SB(0, 0), cB, voffB); PG8_STAGE(PG8_SA(0, 0), cA, voffA); PG8_STAGE(PG8_SB(0, 1), cB + hstep, voffB); PG8_STAGE(PG8_SA(0, 1), cA + hstep, voffA);
        if (wr == 1) PG8_BAR;
        PG8_WAIT_V(4); PG8_BAR;
        PG8_STAGE(PG8_SB(1, 0), cB + kstep, voffB); PG8_STAGE(PG8_SA(1, 0), cA + kstep, voffA); PG8_STAGE(PG8_SB(1, 1), cB + hstep + kstep, voffB);
        PG8_WAIT_V(6); PG8_BAR;
    }
    for (;;) {
        const bool has_next = S.next(ui + 1, nxt);
        const char* nA = has_next ? (const char*)g.A + (size_t)nxt.pm * tstep : cA; const char* nB = has_next ? (const char*)g.Bt + (size_t)nxt.pn * tstep : cB;
        for (int t = 0; t < nt; t += 2) {
            const bool last = (t == nt - 2);
            const char* a1 = cA + (size_t)(t + 1) * kstep;
            const char* a2 = last ? nA : cA + (size_t)(t + 2) * kstep; const char* b2 = last ? nB : cB + (size_t)(t + 2) * kstep;
            const char* a3 = a2 + kstep; const char* b3 = b2 + kstep;
            if (last && has_next) S.a_ready(nxt);
            if constexpr (SP2) {
            PG8_LDB(B0, 0, 0); PG8_LDB(B1, 0, 1); PG8_SCHED; PG8_LDA(At, 0, 0); PG8_STAGE(PG8_SA(1, 1), a1 + hstep, voffA);
            PG8_WAIT_V(8); PG8_WAIT_L(0); PG8_BAR; PG8_MMA(0, 0, At, B0); PG8_MMA(0, 1, At, B1); PG8_BAR; PG8_SCHED;
            PG8_LDA(At, 0, 1); PG8_STAGE(PG8_SB(0, 0), b2, voffB); PG8_STAGE(PG8_SB(0, 1), b2 + hstep, voffB); PG8_STAGE(PG8_SA(0, 0), a2, voffA);
            PG8_WAIT_V(8); PG8_WAIT_L(0); PG8_BAR; PG8_MMA(1, 0, At, B0); PG8_MMA(1, 1, At, B1); PG8_BAR; PG8_SCHED;
            PG8_LDB(B0, 1, 0); PG8_LDB(B1, 1, 1); PG8_SCHED; PG8_LDA(At, 1, 0); PG8_STAGE(PG8_SA(0, 1), a2 + hstep, voffA);
            PG8_WAIT_V(8); PG8_WAIT_L(0); PG8_BAR; PG8_MMA(0, 0, At, B0); PG8_MMA(0, 1, At, B1); PG8_BAR; PG8_SCHED;
            PG8_LDA(At, 1, 1); PG8_STAGE(PG8_SB(1, 0), b3, voffB); PG8_STAGE(PG8_SB(1, 1), b3 + hstep, voffB); PG8_STAGE(PG8_SA(1, 0), a3, voffA);
            PG8_WAIT_V(8); PG8_WAIT_L(0); PG8_BAR; PG8_MMA(1, 0, At, B0); PG8_MMA(1, 1, At, B1); PG8_BAR; PG8_SCHED;
            } else {
            PG8_LDB(B0, 0, 0); PG8_SCHED; PG8_LDA(At, 0, 0); PG8_STAGE(PG8_SA(1, 1), a1 + hstep, voffA);
            PG8_WAIT_L(8); PG8_BAR; PG8_WAIT_L(0); PG8_MMA(0, 0, At, B0); PG8_BAR; PG8_SCHED;
            PG8_LDB(B1, 0, 1); PG8_STAGE(PG8_SB(0, 0), b2, voffB);
            PG8_BAR; PG8_WAIT_L(0); PG8_MMA(0, 1, At, B1); PG8_BAR;
            PG8_LDA(At, 0, 1); PG8_STAGE(PG8_SA(0, 0), a2, voffA);
            PG8_BAR; PG8_WAIT_L(0); PG8_MMA(1, 0, At, B0); PG8_BAR; PG8_SCHED;
            PG8_STAGE(PG8_SB(0, 1), b2 + hstep, voffB);
            PG8_WAIT_V(6); PG8_BAR; PG8_MMA(1, 1, At, B1); PG8_BAR;
            PG8_LDB(B0, 1, 0); PG8_SCHED; PG8_LDA(At, 1, 0); PG8_STAGE(PG8_SA(0, 1), a2 + hstep, voffA);
            PG8_WAIT_L(8); PG8_BAR; PG8_WAIT_L(0); PG8_MMA(0, 0, At, B0); PG8_BAR; PG8_SCHED;
            PG8_LDB(B1, 1, 1); PG8_STAGE(PG8_SB(1, 0), b3, voffB);
            PG8_BAR; PG8_WAIT_L(0); PG8_MMA(0, 1, At, B1); PG8_BAR;
            PG8_LDA(At, 1, 1); PG8_STAGE(PG8_SA(1, 0), a3, voffA);
            PG8_BAR; PG8_WAIT_L(0); PG8_MMA(1, 0, At, B0); PG8_BAR; PG8_SCHED;
            PG8_STAGE(PG8_SB(1, 1), b3 + hstep, voffB);
            PG8_WAIT_V(6); PG8_BAR; PG8_MMA(1, 1, At, B1); PG8_BAR;
            }
        }
        if constexpr (ALIGN_EPI) { if (wr == 0) PG8_BAR; }
        if constexpr (!Epi::AFTER_DRAIN) { run_epi(E, acc, cur, wr, wc, fr, fq); S.done(cur); }
        if (!has_next) break;
#pragma unroll
        for (int a = 0; a < 2; ++a)
#pragma unroll
            for (int b = 0; b < 2; ++b)
#pragma unroll
                for (int m = 0; m < 4; ++m)
#pragma unroll
                    for (int n = 0; n < 2; ++n) acc[a][b][m][n] = (f32x4){0.f, 0.f, 0.f, 0.f};
        cur = nxt; cA = nA; cB = nB; ++ui;
        if constexpr (ALIGN_EPI) { if (wr == 1) PG8_BAR; }
    }
    PG8_WAIT_V(0);
    if constexpr (!ALIGN_EPI) { if (wr == 0) PG8_BAR; }
    PG8_BAR;
    if constexpr (Epi::AFTER_DRAIN) { E.fused(acc, cur, wr, wc, fr, fq, lds, wid, lane); S.done(cur); }
#undef PG8_SA
#undef PG8_SB
#undef PG8_STAGE
#undef PG8_LDA
#undef PG8_LDB
#undef PG8_MMA
#undef PG8_WAIT_V
#undef PG8_WAIT_L
#undef PG8_BAR
#undef PG8_SCHED
}
}

#define LAS __attribute__((address_space(3)))
#define XB_TMO      128
#define XB_XCNT(j)  (256  + 64 * (j))
#define XB_XSUB(j)  (1280 + 64 * (j))
#define XB_XGEN(j)  (2304 + 64 * (j))
#define XB_TOP      3328
#define XB_TOPGEN   3392
#define XCD_BAR_WORDS 3456
#define XB_SPIN_CAP (1u << 18)
__device__ __forceinline__ unsigned xb_ld(unsigned* p)              { return __hip_atomic_load(p, __ATOMIC_RELAXED, __HIP_MEMORY_SCOPE_AGENT); }
__device__ __forceinline__ unsigned xb_add(unsigned* p, unsigned v) { return __hip_atomic_fetch_add(p, v, __ATOMIC_RELAXED, __HIP_MEMORY_SCOPE_AGENT); }
__device__ __forceinline__ unsigned xb_xcc_id() { return (unsigned)__builtin_amdgcn_s_getreg((3 << 11) | 20) & 0xFu; }
#define XB_SPIN(cond, bar) do { unsigned _sp = 0; while (cond) { __builtin_amdgcn_s_sleep(1); \
    if ((++_sp & 255u) == 0u) { if (xb_ld(&(bar)[XB_TMO])) break; if (_sp > XB_SPIN_CAP) { atomicAdd(&(bar)[XB_TMO], 1u); break; } } } } while (0)
struct XcdBarrier { unsigned* bar; unsigned x; volatile LAS unsigned* st; };
__device__ __forceinline__ XcdBarrier xcd_barrier_post(unsigned* bar, volatile LAS unsigned* st) {
    XcdBarrier b; b.bar = bar; b.x = xb_xcc_id(); b.st = st;
    if (threadIdx.x == 0) (void)xb_add(&bar[XB_XCNT(b.x)], 1u);
    return b;
}
__device__ __forceinline__ void xcd_barrier_complete(unsigned* bar, unsigned x, unsigned& nloc, unsigned& nx) {
    const unsigned G = gridDim.x * gridDim.y * gridDim.z;
    unsigned sum, cnt, mine, sp = 0u;
    for (;;) {
        sum = 0u; cnt = 0u; mine = 0u;
#pragma unroll
        for (unsigned j = 0; j < 16; ++j) { const unsigned c = xb_ld(&bar[XB_XCNT(j)]); sum += c; cnt += (c > 0u) ? 1u : 0u; mine = (j == x) ? c : mine; }
        if (sum == G) break;
        __builtin_amdgcn_s_sleep(1);
        if ((++sp & 255u) == 0u) { if (xb_ld(&bar[XB_TMO])) break; if (sp > XB_SPIN_CAP) { atomicAdd(&bar[XB_TMO], 1u); break; } }
    }
    nloc = mine > 0u ? mine : 1u; nx = cnt > 0u ? cnt : 1u;
}
__device__ __forceinline__ void xcd_barrier(const XcdBarrier& b) {
    asm volatile("s_waitcnt vmcnt(0)" ::: "memory");
    __syncthreads();
    if (threadIdx.x == 0) {
        unsigned* bar = b.bar;
        __builtin_amdgcn_s_waitcnt(0);
        unsigned nloc = b.st[0], nx = b.st[1];
        if (nloc == 0u) { xcd_barrier_complete(bar, b.x, nloc, nx); b.st[0] = nloc; b.st[1] = nx; }
        const unsigned old = xb_add(&bar[XB_XSUB(b.x)], 1u);
        const unsigned gen = old / nloc;
        if (old + 1u == (gen + 1u) * nloc) {
            __builtin_amdgcn_fence(__ATOMIC_RELEASE, "agent");
            asm volatile("s_waitcnt vmcnt(0)" ::: "memory");
            const unsigned og = xb_add(&bar[XB_TOP], 1u);
            const unsigned tg = og / nx;
            if (og + 1u == (tg + 1u) * nx) xb_add(&bar[XB_TOPGEN], 1u);
            else XB_SPIN(xb_ld(&bar[XB_TOPGEN]) == tg, bar);
            __builtin_amdgcn_fence(__ATOMIC_ACQUIRE, "agent");
            xb_add(&bar[XB_XGEN(b.x)], 1u);
            asm volatile("s_waitcnt vmcnt(0)" ::: "memory");
        } else {
            XB_SPIN(xb_ld(&bar[XB_XGEN(b.x)]) == gen, bar);
            __builtin_amdgcn_fence(__ATOMIC_ACQUIRE, "agent");
            asm volatile("s_waitcnt vmcnt(0)" ::: "memory");
        }
    }
    __syncthreads();
}


namespace ret {
typedef short v4i16_t __attribute__((ext_vector_type(4)));
constexpr int QP = 528, VP = 144, OSP = 68;
constexpr int L_QS = 0, L_KS = 64 * QP, L_VS = 2 * 64 * QP, L_PS = L_VS + 64 * VP, L_OS0 = L_PS + 64 * VP, L_OS1 = L_OS0 + 64 * OSP * 4, L_END = L_OS1 + 64 * OSP * 4;
static_assert(L_END <= 131072 && (L_KS % 16) == 0 && (L_VS % 16) == 0 && (L_PS % 16) == 0 && (L_OS0 % 16) == 0 && (L_OS1 % 16) == 0, "retention LDS map");
__device__ __forceinline__ v4i16_t trrd(LAS const unsigned char* p) { return __builtin_amdgcn_ds_read_tr16_b64_v4i16((LAS v4i16_t*)p); }
__device__ __forceinline__ bf16x8 cat8(v4i16_t lo, v4i16_t hi) { return (bf16x8){lo[0], lo[1], lo[2], lo[3], hi[0], hi[1], hi[2], hi[3]}; }

__device__ __forceinline__ void scores_phase(const bf16_t* Q, const bf16_t* K, bf16_t* PP, int tid, int G) {
    const int lane = tid & 63, wid = __builtin_amdgcn_readfirstlane(tid >> 6), r = lane & 15, q4 = lane >> 4, tt = wid >> 1, st0 = 2 * (wid & 1);
    for (int ch = blockIdx.x; ch < BATCH * RH * NCH; ch += G) {
        const int cidx = ch & 63, h = (ch >> 6) & 3, b = ch >> 8;
        const size_t row0 = (size_t)b * SEQ + (size_t)cidx * CH;
        const float l2g = ret_l2g(h);
        const bf16_t* qp = Q + (row0 + 16 * tt + r) * 1024 + h * 256 + 8 * q4;
        const bf16_t* kp0 = K + (row0 + 16 * st0 + r) * 1024 + h * 256 + 8 * q4;
        f32x4 d0 = {0.f, 0.f, 0.f, 0.f}, d1 = {0.f, 0.f, 0.f, 0.f};
#pragma unroll
        for (int ks = 0; ks < 8; ++ks) {
            const bf16x8 a = *(const bf16x8*)(qp + 32 * ks), b0 = *(const bf16x8*)(kp0 + 32 * ks), b1 = *(const bf16x8*)(kp0 + 16 * 1024 + 32 * ks);
            d0 = __builtin_amdgcn_mfma_f32_16x16x32_bf16(a, b0, d0, 0, 0, 0);
            d1 = __builtin_amdgcn_mfma_f32_16x16x32_bf16(a, b1, d1, 0, 0, 0);
        }
        bf16_t* pp = PP + (size_t)ch * 4096;
#pragma unroll
        for (int g = 0; g < 4; ++g) { const int t = 16 * tt + 4 * q4 + g, s0 = 16 * st0 + r, s1 = s0 + 16;
            pp[t * 64 + s0] = (bf16_t)f2bf(d0[g] * ret_pfac(l2g, t, s0)); pp[t * 64 + s1] = (bf16_t)f2bf(d1[g] * ret_pfac(l2g, t, s1)); }
    }
}

__device__ __forceinline__ void scan_phase(LAS unsigned char* l3, const bf16_t* Q, const bf16_t* K, const bf16_t* Vd, bf16_t* GY, const bf16_t* PP, float* ssh, int tid) {
    const int lane = tid & 63, wid = __builtin_amdgcn_readfirstlane(tid >> 6), dkh = wid >> 2, dvq = wid & 3, r = lane & 15, q4 = lane >> 4;
    const int bx = blockIdx.x, pair = (bx & 7) * 4 + (bx >> 6), slice = (bx >> 3) & 7, b = pair >> 2, h = pair & 3;
    const float l2g = ret_l2g(h), sdec = exp2f(l2g * 64.f);
    const int ft = tid >> 3, fd8 = (tid & 7) * 8;
    const float qdec = exp2f(l2g * (float)(ft + 1));
    f32x4 S[8];
#pragma unroll
    for (int i = 0; i < 8; ++i) S[i] = (f32x4){0.f, 0.f, 0.f, 0.f};
    const bf16_t* qg = Q + (size_t)b * SEQ * 1024 + h * 256; const bf16_t* kg = K + (size_t)b * SEQ * 1024 + h * 256;
    const bf16_t* vg = Vd + (size_t)b * SEQ * 2048 + h * 512 + slice * 64; bf16_t* gg = GY + (size_t)b * SEQ * 2048 + h * 512 + slice * 64;
    const bf16_t* pg = PP + (size_t)((b * 4 + h) * 64) * 4096;
    u32x4 rq[4], rk[4], rv, rp, rg;
#define RET_LOAD(c) do { const size_t r0_ = (size_t)(c) * CH; \
        _Pragma("unroll") for (int i = 0; i < 4; ++i) { const int p_ = tid + 512 * i, rw_ = p_ >> 5, c8_ = (p_ & 31) * 8; \
            rq[i] = *(const u32x4*)(qg + (r0_ + rw_) * 1024 + c8_); rk[i] = *(const u32x4*)(kg + (r0_ + rw_) * 1024 + c8_); } \
        rv = *(const u32x4*)(vg + (r0_ + ft) * 2048 + fd8); rp = *(const u32x4*)(pg + (size_t)(c) * 4096 + ft * 64 + fd8); rg = *(const u32x4*)(gg + (r0_ + ft) * 2048 + fd8); } while (0)
    RET_LOAD(0);
    for (int c = 0; c < NCH; ++c) {
#pragma unroll
        for (int i = 0; i < 4; ++i) { const int p_ = tid + 512 * i, rw_ = p_ >> 5, c8_ = (p_ & 31) * 8;
            *(LAS u32x4*)(l3 + L_QS + rw_ * QP + c8_ * 2) = rq[i]; *(LAS u32x4*)(l3 + L_KS + rw_ * QP + c8_ * 2) = rk[i]; }
        *(LAS u32x4*)(l3 + L_VS + ft * VP + fd8 * 2) = rv; *(LAS u32x4*)(l3 + L_PS + ft * VP + fd8 * 2) = rp;
        const u32x4 gcur = rg;
        if (c + 1 < NCH) RET_LOAD(c + 1);
        __syncthreads();
        bf16x8 vb[2];
#pragma unroll
        for (int ks = 0; ks < 2; ++ks) { LAS const unsigned char* vp = l3 + L_VS + (32 * ks + 8 * q4 + (r >> 2)) * VP + (16 * dvq + 4 * (r & 3)) * 2;
            vb[ks] = cat8(trrd(vp), trrd(vp + 4 * VP)); }
        f32x4 O[4];
#pragma unroll
        for (int t4 = 0; t4 < 4; ++t4) { const bf16x8 a = *(LAS const bf16x8*)(l3 + L_PS + (16 * t4 + r) * VP + (32 * dkh + 8 * q4) * 2);
            O[t4] = __builtin_amdgcn_mfma_f32_16x16x32_bf16(a, dkh ? vb[1] : vb[0], (f32x4){0.f, 0.f, 0.f, 0.f}, 0, 0, 0); }
#pragma unroll
        for (int m = 0; m < 4; ++m) {
            u32x4 sw; sw.x = pk2(S[2 * m][0], S[2 * m][1]); sw.y = pk2(S[2 * m][2], S[2 * m][3]); sw.z = pk2(S[2 * m + 1][0], S[2 * m + 1][1]); sw.w = pk2(S[2 * m + 1][2], S[2 * m + 1][3]);
            const bf16x8 sb = __builtin_bit_cast(bf16x8, sw);
#pragma unroll
            for (int t4 = 0; t4 < 4; ++t4) { LAS const unsigned char* ap = l3 + L_QS + (16 * t4 + r) * QP + (128 * dkh + 32 * m + 4 * q4) * 2;
                const u32x2 lo = *(LAS const u32x2*)ap, hi = *(LAS const u32x2*)(ap + 32);
                const u32x4 aw = {lo.x, lo.y, hi.x, hi.y};
                O[t4] = __builtin_amdgcn_mfma_f32_16x16x32_bf16(__builtin_bit_cast(bf16x8, aw), sb, O[t4], 0, 0, 0); }
        }
        { LAS float* os = (LAS float*)(l3 + (dkh ? L_OS1 : L_OS0));
#pragma unroll
          for (int t4 = 0; t4 < 4; ++t4)
#pragma unroll
              for (int g = 0; g < 4; ++g) os[(16 * t4 + 4 * q4 + g) * OSP + 16 * dvq + r] = O[t4][g]; }
#pragma unroll
        for (int i = 0; i < 8; ++i) {
            S[i] = S[i] * sdec;
#pragma unroll
            for (int ks = 0; ks < 2; ++ks) { LAS const unsigned char* kp = l3 + L_KS + (32 * ks + 8 * q4 + (r >> 2)) * QP + (128 * dkh + 16 * i + 4 * (r & 3)) * 2;
                S[i] = __builtin_amdgcn_mfma_f32_16x16x32_bf16(cat8(trrd(kp), trrd(kp + 4 * QP)), vb[ks], S[i], 0, 0, 0); }
        }
        __syncthreads();
        { const LAS float* o0 = (const LAS float*)(l3 + L_OS0) + ft * OSP + fd8; const LAS float* o1 = (const LAS float*)(l3 + L_OS1) + ft * OSP + fd8;
          const f32x4 a0 = *(const LAS f32x4*)o0, a1 = *(const LAS f32x4*)(o0 + 4), b0 = *(const LAS f32x4*)o1, b1 = *(const LAS f32x4*)(o1 + 4);
          const f32x4 x0 = (a0 + b0) * qdec, x1 = (a1 + b1) * qdec;
          float part = (x0[0] * x0[0] + x0[1] * x0[1]) + (x0[2] * x0[2] + x0[3] * x0[3]) + (x1[0] * x1[0] + x1[1] * x1[1]) + (x1[2] * x1[2] + x1[3] * x1[3]);
          part += __shfl_xor(part, 1); part += __shfl_xor(part, 2); part += __shfl_xor(part, 4);
          const size_t grow = (size_t)b * SEQ + (size_t)c * CH + ft;
          if ((tid & 7) == 0) atomicAdd(ssh + grow * 4 + h, part);
          u32x4 w; w.x = pk2(bflo(gcur.x) * x0[0], bfhi(gcur.x) * x0[1]); w.y = pk2(bflo(gcur.y) * x0[2], bfhi(gcur.y) * x0[3]);
          w.z = pk2(bflo(gcur.z) * x1[0], bfhi(gcur.z) * x1[1]); w.w = pk2(bflo(gcur.w) * x1[2], bfhi(gcur.w) * x1[3]);
          *(u32x4*)(gg + ((size_t)c * CH + ft) * 2048 + fd8) = w; }
    }
#undef RET_LOAD
    __syncthreads();
}
__device__ __forceinline__ void norm_phase(bf16_t* GY, const float* ssh, int tid, int G) {
    for (size_t i = ((size_t)blockIdx.x * 512 + tid) * 8; i < (size_t)MTOK * 2048; i += (size_t)G * 512 * 8) {
        const size_t m = i >> 11; const int h = (int)((i & 2047) >> 9);
        const float rr = rstd_of(ssh[m * 4 + h], 1.f / 512.f);
        const u32x4 y = *(const u32x4*)(GY + i); u32x4 w;
        w.x = pk2(bflo(y.x) * rr, bfhi(y.x) * rr); w.y = pk2(bflo(y.y) * rr, bfhi(y.y) * rr); w.z = pk2(bflo(y.z) * rr, bfhi(y.z) * rr); w.w = pk2(bflo(y.w) * rr, bfhi(y.w) * rr);
        *(u32x4*)(GY + i) = w;
    }
}
}


namespace att {
typedef float f32x16 __attribute__((ext_vector_type(16)));
constexpr int KP = 144;
constexpr int L_K = 0, L_V = 2 * 64 * KP, L_TB = 4 * 64 * KP, TBN = 384;
__device__ __forceinline__ void attention_phase(LAS unsigned char* l3, const bf16_t* Q2, const bf16_t* K2, const bf16_t* V2, const float* rel_bias, const float* qgain, const float* kgain, bf16_t* O2, int tid) {
    const int lane = tid & 63, wid = __builtin_amdgcn_readfirstlane(tid >> 6), r32 = lane & 31, hi = lane >> 5;
    const int bx = blockIdx.x, b = bx & 7, h = bx >> 4, c4base = ((bx >> 3) & 1) * 8;
    LAS float* TB = (LAS float*)(l3 + L_TB);
    float gq = fabsf(qgain[lane]), gk = fabsf(kgain[lane]), bm = -1e30f;
    for (int j = lane; j < RELT; j += 64) bm = fmaxf(bm, rel_bias[h * RELT + j]);
#pragma unroll
    for (int o = 1; o < 64; o <<= 1) { gq = fmaxf(gq, __shfl_xor(gq, o)); gk = fmaxf(gk, __shfl_xor(gk, o)); bm = fmaxf(bm, __shfl_xor(bm, o)); }
    const float shift = LOG2E * (8.08f * gq * gk + bm);
    __syncthreads();
    for (int u = tid; u < TBN; u += 512) { const int dist = u - 63; TB[u] = rel_bias[h * RELT + (dist > RELCLIP ? RELCLIP : dist) + RELCLIP] * LOG2E - shift; }
    const float cfar = rel_bias[h * RELT + 2 * RELCLIP] * LOG2E - shift;
    __syncthreads();
    const int sr = tid >> 3, sc8 = (tid & 7) * 8;
    const int qi_l = wid >> 1;
    const int qr = 32 * (wid & 1) + r32;
    for (int ui = 0; ui < 8; ++ui) {
        const int c4 = c4base + ui, qi = 4 * c4 + qi_l;
        const int kc_lo = (4 * c4 - PAST) < 0 ? 0 : 4 * c4 - PAST, kc_hi = 4 * c4 + 3;
        const size_t qrow = (size_t)b * SEQ + (size_t)qi * CH + qr;
        bf16x8 qf[4];
#pragma unroll
        for (int ks = 0; ks < 4; ++ks) qf[ks] = *(const bf16x8*)(Q2 + qrow * 1024 + h * 64 + 16 * ks + 8 * hi);
        f32x16 o0, o1; float lsum = 0.f;
#pragma unroll
        for (int g = 0; g < 16; ++g) { o0[g] = 0.f; o1[g] = 0.f; }
        const bf16_t* kbase = K2 + (size_t)b * SEQ * 1024 + h * 64 + (size_t)sr * 1024 + sc8;
        const bf16_t* vbase = V2 + (size_t)b * SEQ * 1024 + h * 64 + (size_t)sr * 1024 + sc8;
        u32x4 rk = *(const u32x4*)(kbase + (size_t)kc_lo * CH * 1024), rv = *(const u32x4*)(vbase + (size_t)kc_lo * CH * 1024);
        int buf = 0;
        for (int kc = kc_lo; kc <= kc_hi; ++kc, buf ^= 1) {
            *(LAS u32x4*)(l3 + L_K + buf * 64 * KP + sr * KP + sc8 * 2) = rk; *(LAS u32x4*)(l3 + L_V + buf * 64 * KP + sr * KP + sc8 * 2) = rv;
            if (kc < kc_hi) { rk = *(const u32x4*)(kbase + (size_t)(kc + 1) * CH * 1024); rv = *(const u32x4*)(vbase + (size_t)(kc + 1) * CH * 1024); }
            __syncthreads();
            const int dc = qi - kc;
            if (dc >= 0 && dc <= PAST) {
                LAS const unsigned char* kb = l3 + L_K + buf * 64 * KP; LAS const unsigned char* vb = l3 + L_V + buf * 64 * KP;
                f32x16 p0, p1;
                if (dc <= 4) {
                    const LAS float* tb = TB + (64 * dc + qr + 63 - 4 * hi - 59);
#pragma unroll
                    for (int g = 0; g < 16; ++g) { p0[g] = tb[59 - ((g & 3) + 8 * (g >> 2))]; p1[g] = tb[59 - (32 + (g & 3) + 8 * (g >> 2))]; }
                } else {
#pragma unroll
                    for (int g = 0; g < 16; ++g) { p0[g] = cfar; p1[g] = cfar; }
                }
#pragma unroll
                for (int ks = 0; ks < 4; ++ks) {
                    const bf16x8 k0 = *(LAS const bf16x8*)(kb + r32 * KP + (16 * ks + 8 * hi) * 2), k1 = *(LAS const bf16x8*)(kb + (32 + r32) * KP + (16 * ks + 8 * hi) * 2);
                    p0 = __builtin_amdgcn_mfma_f32_32x32x16_bf16(k0, qf[ks], p0, 0, 0, 0);
                    p1 = __builtin_amdgcn_mfma_f32_32x32x16_bf16(k1, qf[ks], p1, 0, 0, 0);
                }
                float ls = 0.f;
#pragma unroll
                for (int g = 0; g < 16; ++g) { p0[g] = __builtin_amdgcn_exp2f(p0[g]); p1[g] = __builtin_amdgcn_exp2f(p1[g]); ls += p0[g] + p1[g]; }
                lsum += ls;
                bf16x8 pf[2][2];
#pragma unroll
                for (int s2 = 0; s2 < 2; ++s2) {
                    u32x4 w0, w1;
                    w0.x = pk2(p0[8 * s2 + 0], p0[8 * s2 + 1]); w0.y = pk2(p0[8 * s2 + 2], p0[8 * s2 + 3]); w0.z = pk2(p0[8 * s2 + 4], p0[8 * s2 + 5]); w0.w = pk2(p0[8 * s2 + 6], p0[8 * s2 + 7]);
                    w1.x = pk2(p1[8 * s2 + 0], p1[8 * s2 + 1]); w1.y = pk2(p1[8 * s2 + 2], p1[8 * s2 + 3]); w1.z = pk2(p1[8 * s2 + 4], p1[8 * s2 + 5]); w1.w = pk2(p1[8 * s2 + 6], p1[8 * s2 + 7]);
                    pf[0][s2] = __builtin_bit_cast(bf16x8, w0); pf[1][s2] = __builtin_bit_cast(bf16x8, w1);
                }
                const int i16 = lane & 15, g4 = lane >> 4;
                LAS const unsigned char* vp = vb + (4 * (g4 >> 1) + (i16 >> 2)) * KP + (16 * (g4 & 1) + 4 * (i16 & 3)) * 2;
#pragma unroll
                for (int n = 0; n < 2; ++n)
#pragma unroll
                    for (int s2 = 0; s2 < 2; ++s2) {
                        LAS const unsigned char* vq = vp + (32 * n + 16 * s2) * KP;
                        const bf16x8 a0 = ret::cat8(ret::trrd(vq), ret::trrd(vq + 8 * KP)), a1 = ret::cat8(ret::trrd(vq + 64), ret::trrd(vq + 8 * KP + 64));
                        o0 = __builtin_amdgcn_mfma_f32_32x32x16_bf16(a0, pf[n][s2], o0, 0, 0, 0);
                        o1 = __builtin_amdgcn_mfma_f32_32x32x16_bf16(a1, pf[n][s2], o1, 0, 0, 0);
                    }
            }
        }
        lsum += __shfl_xor(lsum, 32);
        const float il = 1.0f / lsum;
        bf16_t* op = O2 + qrow * 1024 + h * 64 + 4 * hi;
#pragma unroll
        for (int k4 = 0; k4 < 4; ++k4) {
            u32x2 w; w.x = pk2(o0[4 * k4] * il, o0[4 * k4 + 1] * il); w.y = pk2(o0[4 * k4 + 2] * il, o0[4 * k4 + 3] * il); *(u32x2*)(op + 8 * k4) = w;
            u32x2 z; z.x = pk2(o1[4 * k4] * il, o1[4 * k4 + 1] * il); z.y = pk2(o1[4 * k4 + 2] * il, o1[4 * k4 + 3] * il); *(u32x2*)(op + 32 + 8 * k4) = z;
        }
        __syncthreads();
    }
}
}

constexpr int NPH = 13;
constexpr int CW_BAR = 4096;
constexpr int RING_BYTES = 131072, LDSCTL_OFF = RING_BYTES, MISC_OFF = LDSCTL_OFF + 320, LDS_BYTES = 147456;
struct MArgs { Ptrs P; int ph_lo, ph_hi, li, pad; };
#define BFW(off) ((bf16_t*)(ws + (off)))
__global__ void __launch_bounds__(512, 2) mega(MArgs a) {
    extern __shared__ __attribute__((aligned(16))) unsigned char lds[];
    LAS unsigned char* l3 = (LAS unsigned char*)lds;
    volatile LAS unsigned* MISC = (volatile LAS unsigned*)(l3 + MISC_OFF);
    const int tid = threadIdx.x, lane = tid & 63, wave = __builtin_amdgcn_readfirstlane(tid >> 6);
    const int G = gridDim.x;
    unsigned char* ws = a.P.ws;
    for (int u = tid; u < (LDS_BYTES - LDSCTL_OFF) / 4; u += 512) ((LAS unsigned*)(l3 + LDSCTL_OFF))[u] = 0u;
    __syncthreads();
    const XcdBarrier bar = xcd_barrier_post((unsigned*)(ws + WS_CTL) + CW_BAR + a.li * XCD_BAR_WORDS, MISC + 8);
    float *ss0, *ss1, *ss2, *ss3;
    for (int ph = a.ph_lo; ph < a.ph_hi; ++ph) {
        { unsigned long long w_ = (unsigned long long)a.P.ws, o_ = (unsigned long long)a.P.out, x_ = (unsigned long long)a.P.x; asm volatile("" : "+s"(w_), "+s"(o_), "+s"(x_));
          ws = (unsigned char*)w_; a.P.ws = ws; a.P.out = (float*)o_; a.P.x = (const float*)x_; }
        int tl = tid; asm volatile("" : "+v"(tl));
        const int lane_l = tl & 63, wave_l = __builtin_amdgcn_readfirstlane(tl >> 6);
        ss0 = (float*)(ws + WS_SS0); ss1 = (float*)(ws + WS_SS1); ss2 = (float*)(ws + WS_SS2); ss3 = (float*)(ws + WS_SS3);
        if (ph == 0) {
            prologue_phase(a.P, (float*)(lds + wave_l * 16384), (int)blockIdx.x * 8 + wave_l, G * 8, lane_l);
        } else if (ph == 1) {
            pg8::Gemm g{(const bf16_t*)a.P.out, BFW(WS_W1), MTOK, RIN, 1024}; pg8::StaticOrder S; S.init(MTOK, RIN, G, (int)blockIdx.x);
            EpiIn E{ss0, (const float*)(ws + WS_COS), (const float*)(ws + WS_SIN), BFW(WS_Q), BFW(WS_K), BFW(WS_V), BFW(WS_G)};
            pg8::gemm_phase<EpiIn, pg8::StaticOrder, true, true>(l3, g, S, E, tl);
        } else if (ph == 5 || ph == 7 || ph == 10 || ph == 12) {
            const bf16_t* A = ph == 5 ? BFW(WS_G) : ph == 7 ? BFW(WS_H) : ph == 10 ? BFW(WS_O2) : BFW(WS_H);
            const bf16_t* Bt = ph == 5 ? BFW(WS_W2) : ph == 7 ? BFW(WS_W4) : ph == 10 ? BFW(WS_W6) : BFW(WS_W8);
            const int K = ph == 5 ? 2048 : ph == 10 ? 1024 : FF;
            pg8::Gemm g{A, Bt, MTOK, 1024, K}; pg8::StaticOrder S; S.init(MTOK, 1024, G, (int)blockIdx.x);
            EpiRes E{ph == 5 ? a.P.x : (const float*)a.P.out, a.P.out, ph == 5 ? BFW(WS_XH1) : ph == 7 ? BFW(WS_XH2) : ph == 10 ? BFW(WS_XH3) : (bf16_t*)nullptr,
                     ph == 5 ? ss1 : ph == 7 ? ss2 : ph == 10 ? ss3 : (float*)nullptr};
            pg8::gemm_phase<EpiRes, pg8::StaticOrder, true, true>(l3, g, S, E, tl);
        } else if (ph == 6 || ph == 11) {
            pg8::Gemm g{ph == 6 ? BFW(WS_XH1) : BFW(WS_XH3), ph == 6 ? BFW(WS_W3) : BFW(WS_W7), MTOK, 2 * FF, 1024}; pg8::StaticOrder S; S.init(MTOK, 2 * FF, G, (int)blockIdx.x);
            EpiGU E{ph == 6 ? ss1 : ss3, BFW(WS_H)};
            pg8::gemm_phase<EpiGU, pg8::StaticOrder, true, true>(l3, g, S, E, tl);
        } else if (ph == 2) {
            ret::scores_phase(BFW(WS_Q), BFW(WS_K), (bf16_t*)a.P.out + (size_t)32 * MiB, tl, G);
        } else if (ph == 3) {
            ret::scan_phase(l3, BFW(WS_Q), BFW(WS_K), BFW(WS_V), BFW(WS_G), (const bf16_t*)a.P.out + (size_t)32 * MiB, (float*)(ws + WS_SSH), tl);
        } else if (ph == 4) {
            ret::norm_phase(BFW(WS_G), (const float*)(ws + WS_SSH), tl, G);
        } else if (ph == 9) {
            att::attention_phase(l3, BFW(WS_Q2), BFW(WS_K2), BFW(WS_V2), a.P.b_rel_bias, a.P.b_q_norm_g, a.P.k_norm_g, BFW(WS_O2), tl);
        } else if (ph == 8) {
            pg8::Gemm g{BFW(WS_XH2), BFW(WS_W5), MTOK, 3072, 1024}; pg8::StaticOrder S; S.init(MTOK, 3072, G, (int)blockIdx.x);
            EpiKVQ E{ss2, a.P.k_norm_g, a.P.b_q_norm_g, BFW(WS_K2), BFW(WS_V2), BFW(WS_Q2)};
            pg8::gemm_phase<EpiKVQ, pg8::StaticOrder, true, true>(l3, g, S, E, tl);
        }
        if (ph + 1 < a.ph_hi) xcd_barrier(bar);
    }
}
static void launch_mega(const Ptrs& P, int lo, int hi, int li, int grid, hipStream_t stream, bool coop) {
    MArgs a{}; a.P = P; a.ph_lo = lo; a.ph_hi = hi; a.li = li; a.pad = 0;
    bool done = false;
    if (coop) { void* args[] = {(void*)&a}; done = hipLaunchCooperativeKernel((const void*)mega, dim3(grid), dim3(512), args, LDS_BYTES, stream) == hipSuccess;
        if (!done) { (void)hipGetLastError(); fprintf(stderr, "kernel_launch: cooperative launch refused; falling back to a plain launch of the same grid\n"); } }
    if (!done) hipLaunchKernelGGL(mega, dim3(grid), dim3(512), LDS_BYTES, stream, a);
    const hipError_t e = hipPeekAtLastError();
    if (e != hipSuccess) fprintf(stderr, "kernel_launch: mega launch [%d,%d) failed: %s\n", lo, hi, hipGetErrorName(e));
}
extern "C" void kernel_launch(void* const* d_in, const int* in_sizes, int n_in, void* d_out, int out_size, void* d_ws, size_t ws_size, hipStream_t stream) {
    if (n_in != 19 || ws_size < WS_END || out_size != MTOK * DM) { fprintf(stderr, "kernel_launch: unexpected shapes (n_in %d, ws %zu, out %d)\n", n_in, ws_size, out_size); return; }
    Ptrs P{};
    const float** pp = (const float**)&P;
    for (int i = 0; i < 19; ++i) pp[i] = (const float*)d_in[i];
    P.out = (float*)d_out; P.ws = (unsigned char*)d_ws;
    unsigned char* ws = P.ws;
    static int grid = 0;
    if (!grid) {
        (void)hipFuncSetAttribute((const void*)nk_retention, hipFuncAttributeMaxDynamicSharedMemorySize, NR_LDS);
        if (hipFuncSetAttribute((const void*)mega, hipFuncAttributeMaxDynamicSharedMemorySize, LDS_BYTES) != hipSuccess) fprintf(stderr, "kernel_launch: hipFuncSetAttribute(mega) failed\n");
        int dev = 0, cus = 0, per_cu = 0; (void)hipGetDevice(&dev); (void)hipDeviceGetAttribute(&cus, hipDeviceAttributeMultiprocessorCount, dev);
        (void)hipOccupancyMaxActiveBlocksPerMultiprocessor(&per_cu, (const void*)mega, 512, LDS_BYTES);
        if (per_cu < 1) fprintf(stderr, "kernel_launch: occupancy query says %d blocks per CU\n", per_cu);
        (void)hipGetLastError();
        if (cus < 256) fprintf(stderr, "kernel_launch: built for a 256-CU device (got %d CUs)\n", cus);
        grid = 256;
    }
    (void)hipMemsetAsync(ws, 0, ZERO_BYTES, stream);
    float* ssh = (float*)(ws + WS_SSH);
#define BF(off) ((bf16_t*)(ws + (off)))
#if defined(NAIVE_RET) || defined(NAIVE_ATT)
#if defined(NAIVE_RET)
    launch_mega(P, 0, 2, 0, grid, stream, false);
    nk_retention<<<BATCH * RH * 16, 256, NR_LDS, stream>>>(BF(WS_Q), BF(WS_K), BF(WS_V), ssh);
    nk_retnorm<<<MTOK * 2048 / 8 / 256, 256, 0, stream>>>(BF(WS_G), BF(WS_V), ssh);
    launch_mega(P, 5, 9, 1, grid, stream, false);
#else
    launch_mega(P, 0, 9, 0, grid, stream, false);
#endif
#if defined(NAIVE_ATT)
    nk_attention<<<BATCH * AH * NCH, 64, 0, stream>>>(BF(WS_Q2), BF(WS_K2), BF(WS_V2), P.b_rel_bias, BF(WS_O2));
    launch_mega(P, 10, 13, 2, grid, stream, false);
#else
    launch_mega(P, 9, 13, 2, grid, stream, false);
#endif
#else
    launch_mega(P, 0, NPH, 0, grid, stream, true);
#endif
#undef BF
}
```

```cpp
#include <hip/hip_runtime.h>
#include <cstdio>
#include <cstdint>
#include <type_traits>

typedef unsigned short bf16_t;
typedef short bf16x8 __attribute__((ext_vector_type(8)));
typedef float f32x4 __attribute__((ext_vector_type(4)));
typedef float f32x2 __attribute__((ext_vector_type(2)));
typedef unsigned u32x4 __attribute__((ext_vector_type(4)));
typedef unsigned u32x2 __attribute__((ext_vector_type(2)));

constexpr int BATCH = 8, SEQ = 4096, DM = 1024, MTOK = BATCH * SEQ;
constexpr int CH = 64, NCH = SEQ / CH;
constexpr int RH = 4, RDK = 256, RDV = 512, RQC = 1024, RVC = 2048, RIN = 6144;
constexpr int AH = 16, AHD = 64, PAST = 8, RELCLIP = 256, RELT = 513;
constexpr int FF = 2816;
constexpr float EPS = 1e-6f;
constexpr float LOG2E = 1.4426950408889634f;

constexpr size_t MiB = 1u << 20;
constexpr size_t WS_CTL = 0;
constexpr size_t WS_SS1 = 1 * MiB;
constexpr size_t WS_SS2 = WS_SS1 + 128 * 1024;
constexpr size_t WS_SS3 = WS_SS2 + 128 * 1024;
constexpr size_t WS_SSH = 66 * MiB;
constexpr size_t ZERO_BYTES = 2 * MiB;
constexpr size_t WS_SS0 = 2 * MiB;
constexpr size_t WS_COS = 3 * MiB;
constexpr size_t WS_W1 = 8 * MiB, WS_W2 = 20 * MiB, WS_W3 = 24 * MiB, WS_W4 = 35 * MiB, WS_W5 = 41 * MiB, WS_W6 = 47 * MiB, WS_W7 = 49 * MiB, WS_W8 = 60 * MiB;
constexpr size_t WS_Q = 72 * MiB, WS_K = 136 * MiB, WS_V = 200 * MiB, WS_G = 328 * MiB;
constexpr size_t WS_XH1 = 248 * MiB, WS_H = 72 * MiB, WS_XH2 = 328 * MiB;
constexpr size_t WS_K2 = 72 * MiB, WS_V2 = 136 * MiB, WS_Q2 = 200 * MiB, WS_O2 = 264 * MiB, WS_XH3 = 392 * MiB;
constexpr size_t WS_END = 456 * MiB;

struct Ptrs {
    const float *x, *a_norm_g, *a_w_in, *a_gn_g, *a_w_o, *a_ffn_norm_g, *a_w_gu, *a_w_down, *kv_norm_g, *w_kv, *k_norm_g,
                *b_norm_g, *b_w_q, *b_q_norm_g, *b_rel_bias, *b_w_o, *b_ffn_norm_g, *b_w_gu, *b_w_down;
    float* out; unsigned char* ws;
};

__device__ __forceinline__ unsigned f2bf(float f) { unsigned u = __float_as_uint(f); return (u + 0x7fffu + ((u >> 16) & 1u)) >> 16; }
typedef __bf16 bf16x2_t __attribute__((ext_vector_type(2)));
__device__ __forceinline__ unsigned pk2(float lo, float hi) { const f32x2 v = {lo, hi}; const bf16x2_t b = __builtin_convertvector(v, bf16x2_t); return __builtin_bit_cast(unsigned, b); }
__device__ __forceinline__ float bf2f(unsigned short h) { return __uint_as_float((unsigned)h << 16); }
__device__ __forceinline__ float bflo(unsigned w) { return __uint_as_float(w << 16); }
__device__ __forceinline__ float bfhi(unsigned w) { return __uint_as_float(w & 0xffff0000u); }
__device__ __forceinline__ void store8bf(bf16_t* dst, const f32x4 a, const f32x4 b) {
    u32x4 w; w.x = pk2(a[0], a[1]); w.y = pk2(a[2], a[3]); w.z = pk2(b[0], b[1]); w.w = pk2(b[2], b[3]); *(u32x4*)dst = w;
}
template <int MASK> __device__ __forceinline__ float shx(float v) {
    if constexpr (MASK == 32) { const auto r = __builtin_amdgcn_permlane32_swap(__float_as_uint(v), __float_as_uint(v), false, false); return __uint_as_float((threadIdx.x & 32) ? r[0] : r[1]); }
    else return __uint_as_float((unsigned)__builtin_amdgcn_ds_swizzle((int)__float_as_uint(v), 0x1f | (MASK << 10)));
}
template <int MASK> __device__ __forceinline__ float addx(float v) {
    if constexpr (MASK == 32) { const auto r = __builtin_amdgcn_permlane32_swap(__float_as_uint(v), __float_as_uint(v), false, false); return __uint_as_float(r[0]) + __uint_as_float(r[1]); }
    else return v + shx<MASK>(v);
}
template <int MASK> __device__ __forceinline__ float maxx(float v) {
    if constexpr (MASK == 32) { const auto r = __builtin_amdgcn_permlane32_swap(__float_as_uint(v), __float_as_uint(v), false, false); return fmaxf(__uint_as_float(r[0]), __uint_as_float(r[1])); }
    else return fmaxf(v, shx<MASK>(v));
}
__device__ __forceinline__ float rstd_of(float ss, float inv_n) { return __builtin_amdgcn_rsqf(ss * inv_n + EPS); }
__device__ __forceinline__ float silu_f(float g) { return g * __builtin_amdgcn_rcpf(1.f + __builtin_amdgcn_exp2f(-LOG2E * g)); }

enum { MAP_ID = 0, MAP_WIN = 1, MAP_GU = 2, MAP_HEAD = 3 };
struct TrItem { const float* W; int K, Nsrc; bf16_t* WT; int dst_row_off; const float* gain; int map, src_off, Ndst, item; };
__device__ __forceinline__ TrItem tr_decode(const Ptrs& P, int it) {
    unsigned char* ws = P.ws;
    constexpr int I1 = 16 * 192, I2 = 32 * 32, I3 = 16 * 176, I4 = 44 * 32, I5 = 16 * 32, I6 = 16 * 32;
    int r = it;
    if (r < I1) return TrItem{P.a_w_in, 1024, RIN, (bf16_t*)(ws + WS_W1), 0, P.a_norm_g, MAP_WIN, 0, RIN, r}; r -= I1;
    if (r < I2) return TrItem{P.a_w_o, 2048, 1024, (bf16_t*)(ws + WS_W2), 0, P.a_gn_g, MAP_ID, 0, 1024, r}; r -= I2;
    if (r < I3) return TrItem{P.a_w_gu, 1024, 2 * FF, (bf16_t*)(ws + WS_W3), 0, P.a_ffn_norm_g, MAP_GU, 0, 2 * FF, r}; r -= I3;
    if (r < I4) return TrItem{P.a_w_down, FF, 1024, (bf16_t*)(ws + WS_W4), 0, nullptr, MAP_ID, 0, 1024, r}; r -= I4;
    if (r < I5) return TrItem{P.w_kv, 1024, 2048, (bf16_t*)(ws + WS_W5), 0, P.kv_norm_g, MAP_HEAD, 0, 1024, r}; r -= I5;
    if (r < I5) return TrItem{P.w_kv, 1024, 2048, (bf16_t*)(ws + WS_W5), 1024, P.kv_norm_g, MAP_ID, 1024, 1024, r}; r -= I5;
    if (r < I5) return TrItem{P.b_w_q, 1024, 1024, (bf16_t*)(ws + WS_W5), 2048, P.b_norm_g, MAP_HEAD, 0, 1024, r}; r -= I5;
    if (r < I6) return TrItem{P.b_w_o, 1024, 1024, (bf16_t*)(ws + WS_W6), 0, nullptr, MAP_ID, 0, 1024, r}; r -= I6;
    if (r < I3) return TrItem{P.b_w_gu, 1024, 2 * FF, (bf16_t*)(ws + WS_W7), 0, P.b_ffn_norm_g, MAP_GU, 0, 2 * FF, r}; r -= I3;
    return TrItem{P.b_w_down, FF, 1024, (bf16_t*)(ws + WS_W8), 0, nullptr, MAP_ID, 0, 1024, r};
}
__device__ __forceinline__ void tr_load(const TrItem& T, int lane, f32x4 (&wv)[8], float (&gv)[8]) {
    const int nblk = T.Ndst / 32, kb = T.item / nblk, nb = T.item % nblk, k0 = 64 * kb, n0 = 32 * nb;
    int src; float cs = 1.f;
    if (T.map == MAP_GU) { const int pn = n0 >> 8, c = n0 & 255; src = c < 128 ? 128 * pn + c : FF + 128 * pn + (c - 128); }
    else if (T.map == MAP_HEAD) { const int pn = n0 >> 8, c = n0 & 255, bj = c >> 7, wc = (c & 127) >> 5; src = T.src_off + 256 * pn + 64 * wc + 32 * bj; }
    else { src = T.src_off + n0; if (T.map == MAP_WIN && n0 >= 1024 && n0 < 2048) cs = 0.0625f; }
    const int rsub = lane >> 3, c4 = (lane & 7) * 4;
#pragma unroll
    for (int i = 0; i < 8; ++i) { const int kk = 8 * i + rsub; wv[i] = *(const f32x4*)(T.W + (size_t)(k0 + kk) * T.Nsrc + src + c4); gv[i] = T.gain ? T.gain[k0 + kk] * cs : cs; }
}
__device__ __forceinline__ void tr_finish(const TrItem& T, int lane, const f32x4 (&wv)[8], const float (&gv)[8], float* scr) {
    const int nblk = T.Ndst / 32, kb = T.item / nblk, nb = T.item % nblk, k0 = 64 * kb, n0 = 32 * nb;
    { const int rsub = lane >> 3, c4 = (lane & 7) * 4;
#pragma unroll
      for (int i = 0; i < 8; ++i) { float* d = scr + (8 * i + rsub) * 33 + c4; d[0] = wv[i][0] * gv[i]; d[1] = wv[i][1] * gv[i]; d[2] = wv[i][2] * gv[i]; d[3] = wv[i][3] * gv[i]; } }
    __builtin_amdgcn_s_waitcnt(0xc07f); asm volatile("" ::: "memory");
    const int c = lane & 7;
#pragma unroll
    for (int j = 0; j < 4; ++j) { const int n = (lane >> 3) + 8 * j; const float* sp = scr + (8 * c) * 33 + n;
        u32x4 o; o.x = pk2(sp[0 * 33], sp[1 * 33]); o.y = pk2(sp[2 * 33], sp[3 * 33]); o.z = pk2(sp[4 * 33], sp[5 * 33]); o.w = pk2(sp[6 * 33], sp[7 * 33]);
        *(u32x4*)(T.WT + (size_t)(T.dst_row_off + n0 + n) * T.K + k0 + 8 * c) = o; }
    __builtin_amdgcn_s_waitcnt(0xc07f); asm volatile("" ::: "memory");
}
__device__ __forceinline__ float wave_sum(float v) { v = addx<1>(v); v = addx<2>(v); v = addx<4>(v); v = addx<8>(v); v = addx<16>(v); return addx<32>(v); }
__device__ __forceinline__ void prologue_phase(const Ptrs& P, float* scr, int gw, int NGW, int lane) {
    unsigned char* ws = P.ws;
    constexpr int NITEMS = 16 * 192 + 32 * 32 + 2 * (16 * 176) + 2 * (44 * 32) + 3 * (16 * 32) + 16 * 32;
    {   f32x4 wvA[8], wvB[8]; float gvA[8], gvB[8];
        int it = gw;
        if (it < NITEMS) { TrItem TA = tr_decode(P, it); tr_load(TA, lane, wvA, gvA);
            for (;;) {
                const int itB = it + NGW; TrItem TB = tr_decode(P, itB < NITEMS ? itB : it);
                if (itB < NITEMS) tr_load(TB, lane, wvB, gvB);
                tr_finish(TA, lane, wvA, gvA, scr);
                if (itB >= NITEMS) break;
                const int itA = itB + NGW; TA = tr_decode(P, itA < NITEMS ? itA : itB);
                if (itA < NITEMS) tr_load(TA, lane, wvA, gvA);
                tr_finish(TB, lane, wvB, gvB, scr);
                if (itA >= NITEMS) break;
                it = itA;
            } }
    }
    bf16_t* xh0 = (bf16_t*)P.out; float* ss0 = (float*)(ws + WS_SS0);
    {   f32x4 vA[4][4], vB[4][4];
#define XP_LOAD(v, m0) do { _Pragma("unroll") for (int r = 0; r < 4; ++r) { const f32x4* xr = (const f32x4*)(P.x + (size_t)((m0) + r) * DM) + lane; _Pragma("unroll") for (int j = 0; j < 4; ++j) v[r][j] = xr[64 * j]; } } while (0)
#define XP_FIN(v, m0) do { float sq[4]; \
        _Pragma("unroll") for (int r = 0; r < 4; ++r) { float a_ = 0.f; \
            _Pragma("unroll") for (int j = 0; j < 4; ++j) a_ += (v[r][j][0] * v[r][j][0] + v[r][j][1] * v[r][j][1]) + (v[r][j][2] * v[r][j][2] + v[r][j][3] * v[r][j][3]); sq[r] = wave_sum(a_); } \
        _Pragma("unroll") for (int r = 0; r < 4; ++r) { u32x2* o = (u32x2*)(xh0 + (size_t)((m0) + r) * DM) + lane; \
            _Pragma("unroll") for (int j = 0; j < 4; ++j) { u32x2 w; w.x = pk2(v[r][j][0], v[r][j][1]); w.y = pk2(v[r][j][2], v[r][j][3]); o[64 * j] = w; } \
            if (lane == 0) ss0[(m0) + r] = sq[r]; } } while (0)
        const int step = NGW * 4;
        XP_LOAD(vA, gw * 4);
        for (int m0 = gw * 4; m0 < MTOK; m0 += 2 * step) {
            XP_LOAD(vB, m0 + step);
            XP_FIN(vA, m0);
            XP_LOAD(vA, (m0 + 2 * step < MTOK ? m0 + 2 * step : m0));
            XP_FIN(vB, m0 + step);
        }
#undef XP_LOAD
#undef XP_FIN
    }
    unsigned* rcs = (unsigned*)(ws + WS_COS);
    if ((gw & 3) == 0 && (gw >> 2) < 512) {
        const int e = (gw >> 2) * 64 + lane, i = e & 127, pb = e >> 7;
        double th = 1.0; { double bb = 0.9305720409296989792906463164991; int k = i; while (k) { if (k & 1) th *= bb; bb *= bb; k >>= 1; } }
        double c1, s1; { const double t2 = th * th;
            double cs = 1.0 / 2432902008176640000.0; cs = cs * t2 - 1.0 / 6402373705728000.0; cs = cs * t2 + 1.0 / 20922789888000.0; cs = cs * t2 - 1.0 / 87178291200.0; cs = cs * t2 + 1.0 / 479001600.0;
            cs = cs * t2 - 1.0 / 3628800.0; cs = cs * t2 + 1.0 / 40320.0; cs = cs * t2 - 1.0 / 720.0; cs = cs * t2 + 1.0 / 24.0; cs = cs * t2 - 0.5; c1 = cs * t2 + 1.0;
            double sn = 1.0 / 51090942171709440000.0; sn = sn * t2 - 1.0 / 121645100408832000.0; sn = sn * t2 + 1.0 / 355687428096000.0; sn = sn * t2 - 1.0 / 1307674368000.0; sn = sn * t2 + 1.0 / 6227020800.0;
            sn = sn * t2 - 1.0 / 39916800.0; sn = sn * t2 + 1.0 / 362880.0; sn = sn * t2 - 1.0 / 5040.0; sn = sn * t2 + 1.0 / 120.0; sn = sn * t2 - 1.0 / 6.0; s1 = (sn * t2 + 1.0) * th; }
        double cc = 1.0, sc = 0.0; { double bc = c1, bs = s1; int k = 16 * pb;
            while (k) { if (k & 1) { const double nc = cc * bc - sc * bs, ns = cc * bs + sc * bc; cc = nc; sc = ns; }
                const double c2 = bc * bc - bs * bs, s2 = 2.0 * bc * bs; bc = c2; bs = s2; k >>= 1; } }
#pragma unroll 4
        for (int p = 0; p < 16; ++p) { const int pos = pb * 16 + p; const _Float16 hc_ = (_Float16)(float)cc, hs_ = (_Float16)(float)sc;
            rcs[pos * 128 + i] = (unsigned)__builtin_bit_cast(unsigned short, hc_) | ((unsigned)__builtin_bit_cast(unsigned short, hs_) << 16);
            const double nc = cc * c1 - sc * s1, ns = cc * s1 + sc * c1; cc = nc; sc = ns; }
    }
}

__device__ __forceinline__ float ret_l2g(int h) { return h == 0 ? -0.04580368961312479f : h == 1 ? -0.02272007650008353f : h == 2 ? -0.011315313227834146f : -0.005646563141142063f; }
__device__ __forceinline__ float ret_pfac(float l2g, int t, int s) { return exp2f(l2g * (float)(t >= s ? -64 : 2 * (s - t) - 64)); }

#define PG8_LAS_ __attribute__((address_space(3)))
namespace pg8 { struct Unit { int pm, pn; }; }
struct NoLoad {};
struct EpiIn {
    static constexpr bool PERM = true, AFTER_DRAIN = false, KHOOK = false; static constexpr int HB = 4;
    const float* ss; const unsigned* rcs; bf16_t *Q, *K, *V, *G;
    struct Light { float ssv; };
    struct Heavy { u32x4 t0, t1; };
    __device__ __forceinline__ Light lpre(int row, int pn, int wc, int fq) const { Light p; p.ssv = ss[row]; return p; }
    __device__ __forceinline__ Heavy hpre(int row, int pn, int wc, int fq) const {
        Heavy p;
        if (pn < 8) { const int pos = row & (SEQ - 1), c8 = wc * 32 + fq * 8;
            p.t0 = *(const u32x4*)(rcs + pos * 128 + c8); p.t1 = *(const u32x4*)(rcs + pos * 128 + c8 + 4); }
        else { p.t0 = p.t1 = (u32x4){0u, 0u, 0u, 0u}; }
        return p;
    }
    __device__ __forceinline__ void fin(int row, int pn, int wc, int fq, const f32x4 (&v)[2][2], const Light& l, const Heavy& p) const {
        const float rs = rstd_of(l.ssv, 1.f / 1024.f);
        const int c8 = wc * 32 + fq * 8;
        const f32x4 a0 = v[0][0] * rs, a1 = v[0][1] * rs, b0 = v[1][0] * rs, b1 = v[1][1] * rs;
        struct CS { f32x4 c0, c1, s0, s1; } q;
        if (pn < 8) {
#define H2F(w, hi) ((float)__builtin_bit_cast(_Float16, (unsigned short)((hi) ? ((w) >> 16) : ((w) & 0xffffu))))
            q.c0 = (f32x4){H2F(p.t0.x, 0), H2F(p.t0.y, 0), H2F(p.t0.z, 0), H2F(p.t0.w, 0)}; q.s0 = (f32x4){H2F(p.t0.x, 1), H2F(p.t0.y, 1), H2F(p.t0.z, 1), H2F(p.t0.w, 1)};
            q.c1 = (f32x4){H2F(p.t1.x, 0), H2F(p.t1.y, 0), H2F(p.t1.z, 0), H2F(p.t1.w, 0)}; q.s1 = (f32x4){H2F(p.t1.x, 1), H2F(p.t1.y, 1), H2F(p.t1.z, 1), H2F(p.t1.w, 1)};
#undef H2F
        }
        if (pn < 4) {
            bf16_t* dst = Q + (size_t)row * 1024 + pn * 256 + wc * 32 + 16 * (fq & 1) + 4 * (fq >> 1);
            const f32x4 r0 = a0 * q.c0 - b0 * q.s0, r1 = a1 * q.c1 - b1 * q.s1, i0 = a0 * q.s0 + b0 * q.c0, i1 = a1 * q.s1 + b1 * q.c1;
            u32x2 w; w.x = pk2(r0[0], r0[1]); w.y = pk2(r0[2], r0[3]); *(u32x2*)dst = w; w.x = pk2(r1[0], r1[1]); w.y = pk2(r1[2], r1[3]); *(u32x2*)(dst + 8) = w;
            w.x = pk2(i0[0], i0[1]); w.y = pk2(i0[2], i0[3]); *(u32x2*)(dst + 128) = w; w.x = pk2(i1[0], i1[1]); w.y = pk2(i1[2], i1[3]); *(u32x2*)(dst + 136) = w;
        } else if (pn < 8) {
            bf16_t* dst = K + (size_t)row * 1024 + (pn & 3) * 256 + c8;
            store8bf(dst, a0 * q.c0 - b0 * q.s0, a1 * q.c1 - b1 * q.s1);
            store8bf(dst + 128, a0 * q.s0 + b0 * q.c0, a1 * q.s1 + b1 * q.c1);
        } else if (pn < 16) {
            bf16_t* dst = V + (size_t)row * 2048 + (pn - 8) * 256 + c8;
            const float kd = exp2f(ret_l2g((pn - 8) >> 1) * (float)(63 - (row & 63)));
            store8bf(dst, a0 * kd, a1 * kd); store8bf(dst + 128, b0 * kd, b1 * kd);
        } else {
            bf16_t* dst = G + (size_t)row * 2048 + (pn - 16) * 256 + c8;
            f32x4 g[4] = {a0, a1, b0, b1};
#pragma unroll
            for (int i = 0; i < 4; ++i)
#pragma unroll
                for (int e = 0; e < 4; ++e) g[i][e] = silu_f(g[i][e]);
            store8bf(dst, g[0], g[1]); store8bf(dst + 128, g[2], g[3]);
        }
    }
};
template <bool F32BASE> struct EpiRes {
    static constexpr bool PERM = false, AFTER_DRAIN = false, KHOOK = F32BASE; static constexpr int HB = 4;
    const float* basef; const bf16_t* baseh; float* out; bf16_t* xh; float* ss; const float* ssh;
    static constexpr int TAB_OFF = 131072 + 1024;
    template <class Sched> __device__ __forceinline__ void hook_fill(PG8_LAS_ unsigned char* lds, const Sched& S, int tid) const {
        pg8::Unit u; const int i = tid >> 8, rl = tid & 255;
        if (S.next(i, u)) { const float* p = ssh + (size_t)(u.pm * 256 + rl) * 32; float r[4];
#pragma unroll
            for (int h = 0; h < 4; ++h) { const f32x4 a = *(const f32x4*)(p + 8 * h), b = *(const f32x4*)(p + 8 * h + 4); r[h] = rstd_of(((a[0] + a[1]) + (a[2] + a[3])) + ((b[0] + b[1]) + (b[2] + b[3])), 1.f / 512.f); }
            *(PG8_LAS_ f32x4*)(lds + TAB_OFF + i * 4096 + rl * 16) = (f32x4){r[0] * __builtin_amdgcn_rcpf(r[1]), r[1] * __builtin_amdgcn_rcpf(r[2]), r[2] * __builtin_amdgcn_rcpf(r[3]), r[3]}; }
    }
    __device__ __forceinline__ void hook_scale(f32x4 (&acc)[2][2][4][2], PG8_LAS_ unsigned char* lds, int ui, int idx, int wr) const {
        int l2_; asm volatile("v_mbcnt_lo_u32_b32 %0, -1, 0\n\tv_mbcnt_hi_u32_b32 %0, -1, %0" : "=v"(l2_));
        const PG8_LAS_ float* tb = (const PG8_LAS_ float*)(lds + TAB_OFF + (ui & 1) * 4096) + idx + (wr * 64 + (l2_ & 15)) * 4;
#pragma unroll
        for (int ai = 0; ai < 2; ++ai)
#pragma unroll
            for (int m = 0; m < 4; ++m) { const float rho = tb[(128 * ai + 16 * m) * 4];
#pragma unroll
                for (int bj = 0; bj < 2; ++bj)
#pragma unroll
                    for (int n = 0; n < 2; ++n) acc[ai][bj][m][n] = acc[ai][bj][m][n] * rho; }
    }
    struct LightH { u32x2 b[2][2]; };
    struct HeavyF { f32x4 b[2][2]; };
    typedef typename std::conditional<F32BASE, NoLoad, LightH>::type Light;
    typedef typename std::conditional<F32BASE, HeavyF, NoLoad>::type Heavy;
    __device__ __forceinline__ Light lpre(int row, int pn, int wc, int fq) const {
        Light p;
        if constexpr (!F32BASE) { const size_t off0 = (size_t)row * DM + pn * 256 + wc * 32 + 4 * fq;
#pragma unroll
            for (int bj = 0; bj < 2; ++bj)
#pragma unroll
                for (int n = 0; n < 2; ++n) p.b[bj][n] = *(const u32x2*)(baseh + off0 + bj * 128 + n * 16); }
        return p;
    }
    __device__ __forceinline__ Heavy hpre(int row, int pn, int wc, int fq) const {
        Heavy p;
        if constexpr (F32BASE) { const size_t off0 = (size_t)row * DM + pn * 256 + wc * 32 + 4 * fq;
#pragma unroll
            for (int bj = 0; bj < 2; ++bj)
#pragma unroll
                for (int n = 0; n < 2; ++n) p.b[bj][n] = *(const f32x4*)(basef + off0 + bj * 128 + n * 16); }
        return p;
    }
    __device__ __forceinline__ void fin(int row, int pn, int wc, int fq, const f32x4 (&v)[2][2], const Light& l, const Heavy& p) const {
        const size_t off0 = (size_t)row * DM + pn * 256 + wc * 32 + 4 * fq; float part = 0.f;
#pragma unroll
        for (int bj = 0; bj < 2; ++bj)
#pragma unroll
            for (int n = 0; n < 2; ++n) { const size_t off = off0 + bj * 128 + n * 16;
                f32x4 bs;
                if constexpr (F32BASE) bs = p.b[bj][n]; else bs = (f32x4){bflo(l.b[bj][n].x), bfhi(l.b[bj][n].x), bflo(l.b[bj][n].y), bfhi(l.b[bj][n].y)};
                const f32x4 x = bs + v[bj][n];
                if (out) *(f32x4*)(out + off) = x;
                if (xh) { u32x2 w; w.x = pk2(x[0], x[1]); w.y = pk2(x[2], x[3]); *(u32x2*)(xh + off) = w; }
                part += (x[0] * x[0] + x[1] * x[1]) + (x[2] * x[2] + x[3] * x[3]); }
        if (ss) { part = addx<16>(part); part = addx<32>(part); if (fq == 0) atomicAdd(ss + row, part); }
    }
};
struct EpiGU {
    static constexpr bool PERM = true, AFTER_DRAIN = false, KHOOK = false; static constexpr int HB = 4;
    const float* ss; bf16_t* H;
    struct Light { float ssv; };
    typedef NoLoad Heavy;
    __device__ __forceinline__ Light lpre(int row, int pn, int wc, int fq) const { Light p; p.ssv = ss[row]; return p; }
    __device__ __forceinline__ Heavy hpre(int row, int pn, int wc, int fq) const { return Heavy{}; }
    __device__ __forceinline__ void fin(int row, int pn, int wc, int fq, const f32x4 (&v)[2][2], const Light& l, const Heavy&) const {
        const float rs = rstd_of(l.ssv, 1.f / 1024.f);
        f32x4 h[2];
#pragma unroll
        for (int n = 0; n < 2; ++n)
#pragma unroll
            for (int e = 0; e < 4; ++e) { const float g = v[0][n][e] * rs, u = v[1][n][e] * rs; h[n][e] = silu_f(g) * u; }
        store8bf(H + (size_t)row * FF + pn * 128 + wc * 32 + fq * 8, h[0], h[1]);
    }
};
struct EpiKVQ {
    static constexpr bool PERM = true, AFTER_DRAIN = false, KHOOK = false; static constexpr int HB = 4;
    const float* ss; const float* kg; const float* qg; bf16_t *K2, *V2, *Q2;
    struct Light { float ssv; };
    typedef NoLoad Heavy;
    __device__ __forceinline__ Light lpre(int row, int pn, int wc, int fq) const { Light p; p.ssv = ss[row]; return p; }
    __device__ __forceinline__ Heavy hpre(int row, int pn, int wc, int fq) const { return Heavy{}; }
    __device__ __forceinline__ void fin(int row, int pn, int wc, int fq, const f32x4 (&v)[2][2], const Light& l, const Heavy&) const {
        const float rs = rstd_of(l.ssv, 1.f / 1024.f);
        const int t = pn >> 2, pl = pn & 3;
        f32x4 x[2][2]; float s = 0.f;
#pragma unroll
        for (int bj = 0; bj < 2; ++bj)
#pragma unroll
            for (int n = 0; n < 2; ++n) { x[bj][n] = v[bj][n] * rs; s += (x[bj][n][0] * x[bj][n][0] + x[bj][n][1] * x[bj][n][1]) + (x[bj][n][2] * x[bj][n][2] + x[bj][n][3] * x[bj][n][3]); }
        if (t == 1) {
            bf16_t* dst = V2 + (size_t)row * 1024 + pl * 256 + wc * 32 + fq * 8;
            store8bf(dst, x[0][0], x[0][1]); store8bf(dst + 128, x[1][0], x[1][1]);
        } else {
            s = addx<16>(s); s = addx<32>(s);
            const float rh = rstd_of(s, 1.f / 64.f) * (t == 2 ? 0.125f * LOG2E : 1.f);
            const float* gp = (t == 0 ? kg : qg) + fq * 8;
            bf16_t* dst = (t == 0 ? K2 : Q2) + (size_t)row * 1024 + (4 * pl + wc) * 64 + fq * 8;
#pragma unroll
            for (int bj = 0; bj < 2; ++bj) { const f32x4 g0 = *(const f32x4*)(gp + 32 * bj), g1 = *(const f32x4*)(gp + 32 * bj + 4);
                store8bf(dst + 32 * bj, x[bj][0] * g0 * rh, x[bj][1] * g1 * rh); }
        }
    }
};

namespace pg8 {
#define PG8_LAS __attribute__((address_space(3)))
typedef unsigned short bf16_t;
typedef short bf16x8 __attribute__((ext_vector_type(8)));
typedef float f32x4 __attribute__((ext_vector_type(4)));
typedef unsigned u32x4 __attribute__((ext_vector_type(4)));
constexpr int BM = 256, BK = 64, HALF = 128, HTB = HALF * BK * 2  , STAGE_BYTES = 8 * HTB, NXCD = 8, WGM = 8;

__host__ __device__ __forceinline__ int lds_byte(int r, int c) { const int st = (r >> 4) * 2 + (c >> 5), rr = r & 15, cc = c & 31, ob = rr * 64 + cc * 2; return st * 1024 + (ob ^ (((ob >> 9) & 1) << 5)); }
__host__ __device__ __forceinline__ void stage_rc(int b, int& R, int& C) { const int st = b / 1024, sb = b % 1024, swz = sb ^ (((sb >> 9) & 1) << 5); R = (st >> 1) * 16 + swz / 64; C = (st & 1) * 32 + (swz % 64) / 2; }
__host__ __device__ __forceinline__ int perm32(int rho) { const int n = rho >> 4, i = rho & 15; return 8 * (i >> 2) + 4 * n + (i & 3); }

struct Gemm { const bf16_t* A; const bf16_t* Bt; int M, N, K; };

struct StaticOrder {
    int nM, nN, nwg, G, c;
    __host__ __device__ void init(int M, int N, int G_, int c_) { nM = M / BM; nN = N / BM; nwg = nM * nN; G = G_; c = c_; }
    __host__ __device__ bool next(int i, Unit& u) const {
        const long L = (long)i * G + c; if (L >= nwg) return false;
        int wgid = (int)L; { const int q = nwg / NXCD, r = nwg % NXCD, xcd = wgid % NXCD, off = wgid / NXCD; wgid = (xcd < r ? xcd * (q + 1) : r * (q + 1) + (xcd - r) * q) + off; }
        const int nig = WGM * nN, gid = wgid / nig, fm = gid * WGM, gsz = (nM - fm) < WGM ? (nM - fm) : WGM;
        u.pm = fm + ((wgid % nig) % gsz); u.pn = (wgid % nig) / gsz; return true;
    }
    __device__ __forceinline__ void a_ready(const Unit&) const {}
    __device__ __forceinline__ void done(const Unit&) const {}
};
__device__ __forceinline__ unsigned cvt_pk_bf16(float lo, float hi) { unsigned r; asm volatile("v_cvt_pk_bf16_f32 %0, %1, %2" : "=v"(r) : "v"(lo), "v"(hi)); return r; }

template <class Epi> __device__ __forceinline__ void run_epi(const Epi& E, const f32x4 (&acc)[2][2][4][2], const Unit& u, int wr, int wc, int fr, int fq) {
    typename Epi::Light lp[2][4];
#pragma unroll
    for (int ai = 0; ai < 2; ++ai)
#pragma unroll
        for (int m = 0; m < 4; ++m) lp[ai][m] = E.lpre(u.pm * BM + ai * HALF + wr * 64 + m * 16 + fr, u.pn, wc, fq);
#pragma unroll
    for (int b0 = 0; b0 < 8; b0 += Epi::HB) {
        typename Epi::Heavy hp[Epi::HB];
#pragma unroll
        for (int j = 0; j < Epi::HB; ++j) { const int ai = (b0 + j) >> 2, m = (b0 + j) & 3; hp[j] = E.hpre(u.pm * BM + ai * HALF + wr * 64 + m * 16 + fr, u.pn, wc, fq); }
#pragma unroll
        for (int j = 0; j < Epi::HB; ++j) { const int ai = (b0 + j) >> 2, m = (b0 + j) & 3;
            const f32x4 v[2][2] = {{acc[ai][0][m][0], acc[ai][0][m][1]}, {acc[ai][1][m][0], acc[ai][1][m][1]}};
            E.fin(u.pm * BM + ai * HALF + wr * 64 + m * 16 + fr, u.pn, wc, fq, v, lp[ai][m], hp[j]);
        }
        asm volatile("" ::: "memory");
    }
}
template <class Epi, class Sched, bool ALIGN_EPI = false, bool SP2 = false>
__device__ __forceinline__ void gemm_phase(PG8_LAS unsigned char* lds, const Gemm g, const Sched& S, const Epi& E, const int tid) {
    const int wid = __builtin_amdgcn_readfirstlane(tid >> 6), lane = tid & 63, wr = wid >> 2, wc = wid & 3, fr = lane & 15, fq = lane >> 4;
    const int K = g.K, nt = K / BK;
    unsigned voffA[2], voffB[2];
#pragma unroll
    for (int i = 0; i < 2; ++i) { int R, C; stage_rc(tid * 16 + i * 8192, R, C); const int Rb = Epi::PERM ? ((R & ~31) + perm32(R & 31)) : R;
        voffA[i] = (unsigned)(R * K + C) * 2u; voffB[i] = (unsigned)(Rb * K + C) * 2u; }
    const size_t kstep = (size_t)(BK * 2);
    const size_t hstep = (size_t)HALF * K * 2;
    const size_t tstep = 2 * hstep;
    const unsigned ldsw = (unsigned)wid * 1024u;
    const int aoff = lds_byte(wr * 64 + fr, fq * 8), boff = lds_byte(wc * 32 + fr, fq * 8);
#define PG8_SA(b, h) (((b) * 2 + (h)) * HTB)
#define PG8_SB(b, h) ((4 + (b) * 2 + (h)) * HTB)
#define PG8_STAGE(bufoff, gbase, voff) do { _Pragma("unroll") for (int _i = 0; _i < 2; ++_i) \
        __builtin_amdgcn_global_load_lds((const unsigned*)((const char*)(gbase) + (voff)[_i]), (PG8_LAS unsigned*)(lds + (bufoff) + ldsw + _i * 8192), 16, 0, 0); } while (0)
#define PG8_LDA(dst, b, h) do { _Pragma("unroll") for (int m = 0; m < 4; ++m) _Pragma("unroll") for (int k = 0; k < 2; ++k) dst[m][k] = *(const PG8_LAS bf16x8*)(lds + PG8_SA(b, h) + aoff + m * 2048 + k * 1024); } while (0)
#define PG8_LDB(dst, b, h) do { _Pragma("unroll") for (int n = 0; n < 2; ++n) _Pragma("unroll") for (int k = 0; k < 2; ++k) dst[n][k] = *(const PG8_LAS bf16x8*)(lds + PG8_SB(b, h) + boff + n * 2048 + k * 1024); } while (0)
#define PG8_MMA(ai, bj, At, Bt) do { __builtin_amdgcn_s_setprio(1); _Pragma("unroll") for (int m = 0; m < 4; ++m) _Pragma("unroll") for (int n = 0; n < 2; ++n) _Pragma("unroll") for (int k = 0; k < 2; ++k) \
        acc[ai][bj][m][n] = __builtin_amdgcn_mfma_f32_16x16x32_bf16(Bt[n][k], At[m][k], acc[ai][bj][m][n], 0, 0, 0); __builtin_amdgcn_s_setprio(0); } while (0)
#define PG8_WAIT_V(n) asm volatile("s_waitcnt vmcnt(" #n ")" ::: "memory")
#define PG8_WAIT_L(n) asm volatile("s_waitcnt lgkmcnt(" #n ")" ::: "memory")
#define PG8_BAR __builtin_amdgcn_s_barrier()
#define PG8_SCHED __builtin_amdgcn_sched_barrier(0)
    Unit cur, nxt; int ui = 0;
    if (!S.next(0, cur)) return;
    f32x4 acc[2][2][4][2];
#pragma unroll
    for (int a = 0; a < 2; ++a)
#pragma unroll
        for (int b = 0; b < 2; ++b)
#pragma unroll
            for (int m = 0; m < 4; ++m)
#pragma unroll
                for (int n = 0; n < 2; ++n) acc[a][b][m][n] = (f32x4){0.f, 0.f, 0.f, 0.f};
    bf16x8 At[4][2], B0[2][2], B1[2][2];
    const char* cA = (const char*)g.A + (size_t)cur.pm * tstep; const char* cB = (const char*)g.Bt + (size_t)cur.pn * tstep;
    S.a_ready(cur);
    if constexpr (Epi::KHOOK) { E.hook_fill(lds, S, tid); asm volatile("s_waitcnt lgkmcnt(0)" ::: "memory"); PG8_BAR; asm volatile("" ::: "memory"); }
    if constexpr (SP2) {
        PG8_STAGE(PG8_SB(0, 0), cB, voffB); PG8_STAGE(PG8_SB(0, 1), cB + hstep, voffB); PG8_STAGE(PG8_SA(0, 0), cA, voffA); PG8_STAGE(PG8_SA(0, 1), cA + hstep, voffA);
        if (wr == 1) PG8_BAR;
        PG8_WAIT_V(2); PG8_BAR;
        PG8_STAGE(PG8_SB(1, 0), cB + kstep, voffB); PG8_STAGE(PG8_SA(1, 0), cA + kstep, voffA); PG8_STAGE(PG8_SB(1, 1), cB + hstep + kstep, voffB);
        PG8_WAIT_V(6); PG8_BAR;
    } else {
        PG8_STAGE(PG8_SB(0, 0), cB, voffB); PG8_STAGE(PG8_SA(0, 0), cA, voffA); PG8_STAGE(PG8_SB(0, 1), cB + hstep, voffB); PG8_STAGE(PG8_SA(0, 1), cA + hstep, voffA);
        if (wr == 1) PG8_BAR;
        PG8_WAIT_V(4); PG8_BAR;
        PG8_STAGE(PG8_SB(1, 0), cB + kstep, voffB); PG8_STAGE(PG8_SA(1, 0), cA + kstep, voffA); PG8_STAGE(PG8_SB(1, 1), cB + hstep + kstep, voffB);
        PG8_WAIT_V(6); PG8_BAR;
    }
    for (;;) {
        const bool has_next = S.next(ui + 1, nxt);
        const char* nA = has_next ? (const char*)g.A + (size_t)nxt.pm * tstep : cA; const char* nB = has_next ? (const char*)g.Bt + (size_t)nxt.pn * tstep : cB;
        for (int t = 0; t < nt; t += 2) {
            if constexpr (Epi::KHOOK) { if (t != 0 && (t & 7) == 0) E.hook_scale(acc, lds, ui, (t >> 3) - 1, wr); }
            const bool last = (t == nt - 2);
            const char* a1 = cA + (size_t)(t + 1) * kstep;
            const char* a2 = last ? nA : cA + (size_t)(t + 2) * kstep; const char* b2 = last ? nB : cB + (size_t)(t + 2) * kstep;
            const char* a3 = a2 + kstep; const char* b3 = b2 + kstep;
            if (last && has_next) S.a_ready(nxt);
            if constexpr (SP2) {
            PG8_LDB(B0, 0, 0); PG8_LDB(B1, 0, 1); PG8_SCHED; PG8_LDA(At, 0, 0); PG8_STAGE(PG8_SA(1, 1), a1 + hstep, voffA);
            PG8_WAIT_V(8); PG8_WAIT_L(0); PG8_BAR; PG8_MMA(0, 0, At, B0); PG8_MMA(0, 1, At, B1); PG8_BAR; PG8_SCHED;
            PG8_LDA(At, 0, 1); PG8_STAGE(PG8_SB(0, 0), b2, voffB); PG8_STAGE(PG8_SB(0, 1), b2 + hstep, voffB); PG8_STAGE(PG8_SA(0, 0), a2, voffA);
            PG8_WAIT_V(8); PG8_WAIT_L(0); PG8_BAR; PG8_MMA(1, 0, At, B0); PG8_MMA(1, 1, At, B1); PG8_BAR; PG8_SCHED;
            PG8_LDB(B0, 1, 0); PG8_LDB(B1, 1, 1); PG8_SCHED; PG8_LDA(At, 1, 0); PG8_STAGE(PG8_SA(0, 1), a2 + hstep, voffA);
            PG8_WAIT_V(8); PG8_WAIT_L(0); PG8_BAR; PG8_MMA(0, 0, At, B0); PG8_MMA(0, 1, At, B1); PG8_BAR; PG8_SCHED;
            PG8_LDA(At, 1, 1); PG8_STAGE(PG8_SB(1, 0), b3, voffB); PG8_STAGE(PG8_SB(1, 1), b3 + hstep, voffB); PG8_STAGE(PG8_SA(1, 0), a3, voffA);
            PG8_WAIT_V(8); PG8_WAIT_L(0); PG8_BAR; PG8_MMA(1, 0, At, B0); PG8_MMA(1, 1, At, B1); PG8_BAR; PG8_SCHED;
            } else {
            PG8_LDB(B0, 0, 0); PG8_SCHED; PG8_LDA(At, 0, 0); PG8_STAGE(PG8_SA(1, 1), a1 + hstep, voffA);
            PG8_WAIT_L(8); PG8_BAR; PG8_WAIT_L(0); PG8_MMA(0, 0, At, B0); PG8_BAR; PG8_SCHED;
            PG8_LDB(B1, 0, 1); PG8_STAGE(PG8_SB(0, 0), b2, voffB);
            PG8_BAR; PG8_WAIT_L(0); PG8_MMA(0, 1, At, B1); PG8_BAR;
            PG8_LDA(At, 0, 1); PG8_STAGE(PG8_SA(0, 0), a2, voffA);
            PG8_BAR; PG8_WAIT_L(0); PG8_MMA(1, 0, At, B0); PG8_BAR; PG8_SCHED;
            PG8_STAGE(PG8_SB(0, 1), b2 + hstep, voffB);
            PG8_WAIT_V(6); PG8_BAR; PG8_MMA(1, 1, At, B1); PG8_BAR;
            PG8_LDB(B0, 1, 0); PG8_SCHED; PG8_LDA(At, 1, 0); PG8_STAGE(PG8_SA(0, 1), a2 + hstep, voffA);
            PG8_WAIT_L(8); PG8_BAR; PG8_WAIT_L(0); PG8_MMA(0, 0, At, B0); PG8_BAR; PG8_SCHED;
            PG8_LDB(B1, 1, 1); PG8_STAGE(PG8_SB(1, 0), b3, voffB);
            PG8_BAR; PG8_WAIT_L(0); PG8_MMA(0, 1, At, B1); PG8_BAR;
            PG8_LDA(At, 1, 1); PG8_STAGE(PG8_SA(1, 0), a3, voffA);
            PG8_BAR; PG8_WAIT_L(0); PG8_MMA(1, 0, At, B0); PG8_BAR; PG8_SCHED;
            PG8_STAGE(PG8_SB(1, 1), b3 + hstep, voffB);
            PG8_WAIT_V(6); PG8_BAR; PG8_MMA(1, 1, At, B1); PG8_BAR;
            }
        }
        if constexpr (Epi::KHOOK) E.hook_scale(acc, lds, ui, (nt >> 3) - 1, wr);
        if constexpr (ALIGN_EPI) { if (wr == 0) PG8_BAR; }
        if constexpr (!Epi::AFTER_DRAIN) { int l2_; asm volatile("v_mbcnt_lo_u32_b32 %0, -1, 0\n\tv_mbcnt_hi_u32_b32 %0, -1, %0" : "=v"(l2_));
            run_epi(E, acc, cur, wr, wc, l2_ & 15, l2_ >> 4); S.done(cur); }
        if (!has_next) break;
#pragma unroll
        for (int a = 0; a < 2; ++a)
#pragma unroll
            for (int b = 0; b < 2; ++b)
#pragma unroll
                for (int m = 0; m < 4; ++m)
#pragma unroll
                    for (int n = 0; n < 2; ++n) acc[a][b][m][n] = (f32x4){0.f, 0.f, 0.f, 0.f};
        cur = nxt; cA = nA; cB = nB; ++ui;
        if constexpr (ALIGN_EPI) { if (wr == 1) PG8_BAR; }
    }
    PG8_WAIT_V(0);
    if constexpr (!ALIGN_EPI) { if (wr == 0) PG8_BAR; }
    PG8_BAR;
    if constexpr (Epi::AFTER_DRAIN) { E.fused(acc, cur, wr, wc, fr, fq, lds, wid, lane); S.done(cur); }
#undef PG8_SA
#undef PG8_SB
#undef PG8_STAGE
#undef PG8_LDA
#undef PG8_LDB
#undef PG8_MMA
#undef PG8_WAIT_V
#undef PG8_WAIT_L
#undef PG8_BAR
#undef PG8_SCHED
}
}

#define LAS __attribute__((address_space(3)))
#define XB_TMO      128
#define XB_XCNT(j)  (256  + 64 * (j))
#define XB_XSUB(j)  (1280 + 64 * (j))
#define XB_XGEN(j)  (2304 + 64 * (j))
#define XB_TOP      3328
#define XB_TOPGEN   3392
#define XCD_BAR_WORDS 3456
#define XB_SPIN_CAP (1u << 18)
__device__ __forceinline__ unsigned xb_ld(unsigned* p)              { return __hip_atomic_load(p, __ATOMIC_RELAXED, __HIP_MEMORY_SCOPE_AGENT); }
__device__ __forceinline__ unsigned xb_add(unsigned* p, unsigned v) { return __hip_atomic_fetch_add(p, v, __ATOMIC_RELAXED, __HIP_MEMORY_SCOPE_AGENT); }
__device__ __forceinline__ unsigned xb_xcc_id() { return (unsigned)__builtin_amdgcn_s_getreg((3 << 11) | 20) & 0xFu; }
#define XB_SPIN(cond, bar) do { unsigned _sp = 0; while (cond) { __builtin_amdgcn_s_sleep(1); \
    if ((++_sp & 255u) == 0u) { if (xb_ld(&(bar)[XB_TMO])) break; if (_sp > XB_SPIN_CAP) { atomicAdd(&(bar)[XB_TMO], 1u); break; } } } } while (0)
struct XcdBarrier { unsigned* bar; unsigned x; volatile LAS unsigned* st; };
__device__ __forceinline__ XcdBarrier xcd_barrier_post(unsigned* bar, volatile LAS unsigned* st) {
    XcdBarrier b; b.bar = bar; b.x = xb_xcc_id(); b.st = st;
    if (threadIdx.x == 0) (void)xb_add(&bar[XB_XCNT(b.x)], 1u);
    return b;
}
__device__ __forceinline__ void xcd_barrier_complete(unsigned* bar, unsigned x, unsigned& nloc, unsigned& nx) {
    const unsigned G = gridDim.x * gridDim.y * gridDim.z;
    unsigned sum, cnt, mine, sp = 0u;
    for (;;) {
        sum = 0u; cnt = 0u; mine = 0u;
#pragma unroll
        for (unsigned j = 0; j < 16; ++j) { const unsigned c = xb_ld(&bar[XB_XCNT(j)]); sum += c; cnt += (c > 0u) ? 1u : 0u; mine = (j == x) ? c : mine; }
        if (sum == G) break;
        __builtin_amdgcn_s_sleep(1);
        if ((++sp & 255u) == 0u) { if (xb_ld(&bar[XB_TMO])) break; if (sp > XB_SPIN_CAP) { atomicAdd(&bar[XB_TMO], 1u); break; } }
    }
    nloc = mine > 0u ? mine : 1u; nx = cnt > 0u ? cnt : 1u;
}
__device__ __forceinline__ void xcd_barrier(const XcdBarrier& b) {
    asm volatile("s_waitcnt vmcnt(0)" ::: "memory");
    __syncthreads();
    if (threadIdx.x == 0) {
        unsigned* bar = b.bar;
        __builtin_amdgcn_s_waitcnt(0);
        unsigned nloc = b.st[0], nx = b.st[1];
        if (nloc == 0u) { xcd_barrier_complete(bar, b.x, nloc, nx); b.st[0] = nloc; b.st[1] = nx; }
        const unsigned old = xb_add(&bar[XB_XSUB(b.x)], 1u);
        const unsigned gen = old / nloc;
        if (old + 1u == (gen + 1u) * nloc) {
            __builtin_amdgcn_fence(__ATOMIC_RELEASE, "agent");
            asm volatile("s_waitcnt vmcnt(0)" ::: "memory");
            const unsigned og = xb_add(&bar[XB_TOP], 1u);
            const unsigned tg = og / nx;
            if (og + 1u == (tg + 1u) * nx) xb_add(&bar[XB_TOPGEN], 1u);
            else XB_SPIN(xb_ld(&bar[XB_TOPGEN]) == tg, bar);
            __builtin_amdgcn_fence(__ATOMIC_ACQUIRE, "agent");
            xb_add(&bar[XB_XGEN(b.x)], 1u);
            asm volatile("s_waitcnt vmcnt(0)" ::: "memory");
        } else {
            XB_SPIN(xb_ld(&bar[XB_XGEN(b.x)]) == gen, bar);
            __builtin_amdgcn_fence(__ATOMIC_ACQUIRE, "agent");
            asm volatile("s_waitcnt vmcnt(0)" ::: "memory");
        }
    }
    __syncthreads();
}


namespace ret {
typedef short v4i16_t __attribute__((ext_vector_type(4)));
constexpr int QP = 528, KSP = 544, VP = 144, OSP = 68;
constexpr int L_QS = 0, L_KS = 64 * QP, L_VS = 64 * QP + 64 * KSP, L_PS = L_VS + 64 * VP, L_OS0 = L_PS + 64 * VP, L_OS1 = L_OS0 + 64 * OSP * 4, L_END = L_OS1 + 64 * OSP * 4;
static_assert(L_END <= 131072 && (L_KS % 16) == 0 && (L_VS % 16) == 0 && (L_PS % 16) == 0 && (L_OS0 % 16) == 0 && (L_OS1 % 16) == 0, "retention LDS map");
__device__ __forceinline__ v4i16_t trrd(LAS const unsigned char* p) { return __builtin_amdgcn_ds_read_tr16_b64_v4i16((LAS v4i16_t*)p); }
__device__ __forceinline__ bf16x8 cat8(v4i16_t lo, v4i16_t hi) { return (bf16x8){lo[0], lo[1], lo[2], lo[3], hi[0], hi[1], hi[2], hi[3]}; }

__device__ __forceinline__ void scores_phase(LAS unsigned char* l3, const bf16_t* Q, const bf16_t* K, bf16_t* PP, int tid, int G, int bx) {
    const int lane = tid & 63, wid = __builtin_amdgcn_readfirstlane(tid >> 6), r = lane & 15, q4 = lane >> 4, tt = wid >> 1, st0 = 2 * (wid & 1);
    constexpr int NCHH = BATCH * RH * NCH;
    u32x4 rq[4], rk[4];
#define SC_LOAD(ch) do { const int ch_ = (ch) < NCHH ? (ch) : NCHH - 1; const int cidx_ = ch_ & 63, h_ = (ch_ >> 6) & 3, b_ = ch_ >> 8; \
        const size_t row0_ = (size_t)b_ * SEQ + (size_t)cidx_ * CH; \
        _Pragma("unroll") for (int i = 0; i < 4; ++i) { const int p_ = tid + 512 * i, rw_ = p_ >> 5, c8_ = (p_ & 31) * 8; \
            rq[i] = *(const u32x4*)(Q + (row0_ + rw_) * 1024 + h_ * 256 + c8_); rk[i] = *(const u32x4*)(K + (row0_ + rw_) * 1024 + h_ * 256 + c8_); } } while (0)
    SC_LOAD(bx);
    for (int ch = bx; ch < NCHH; ch += G) {
        __syncthreads();
#pragma unroll
        for (int i = 0; i < 4; ++i) { const int p_ = tid + 512 * i, rw_ = p_ >> 5, c8_ = (p_ & 31) * 8;
            *(LAS u32x4*)(l3 + L_QS + rw_ * QP + c8_ * 2) = rq[i]; *(LAS u32x4*)(l3 + L_KS + rw_ * QP + c8_ * 2) = rk[i]; }
        SC_LOAD(ch + G);
        __syncthreads();
        const int h_ = (ch >> 6) & 3; const float l2g = ret_l2g(h_);
        f32x4 d0 = {0.f, 0.f, 0.f, 0.f}, d1 = {0.f, 0.f, 0.f, 0.f};
#pragma unroll
        for (int ks = 0; ks < 8; ++ks) {
            const bf16x8 a = *(LAS const bf16x8*)(l3 + L_QS + (16 * tt + r) * QP + (32 * ks + 8 * q4) * 2);
            LAS const unsigned char* kp0 = l3 + L_KS + (16 * st0 + r) * QP + (32 * ks + 4 * q4) * 2;
            const u32x2 l0 = *(LAS const u32x2*)kp0, h0 = *(LAS const u32x2*)(kp0 + 32), l1 = *(LAS const u32x2*)(kp0 + 16 * QP), h1 = *(LAS const u32x2*)(kp0 + 16 * QP + 32);
            const u32x4 w0 = {l0.x, l0.y, h0.x, h0.y}, w1 = {l1.x, l1.y, h1.x, h1.y};
            d0 = __builtin_amdgcn_mfma_f32_16x16x32_bf16(a, __builtin_bit_cast(bf16x8, w0), d0, 0, 0, 0);
            d1 = __builtin_amdgcn_mfma_f32_16x16x32_bf16(a, __builtin_bit_cast(bf16x8, w1), d1, 0, 0, 0);
        }
        bf16_t* pp = PP + (size_t)ch * 4096;
#pragma unroll
        for (int g = 0; g < 4; ++g) { const int t = 16 * tt + 4 * q4 + g, s0 = 16 * st0 + r, s1 = s0 + 16;
            pp[t * 64 + s0] = (bf16_t)f2bf(d0[g] * ret_pfac(l2g, t, s0)); pp[t * 64 + s1] = (bf16_t)f2bf(d1[g] * ret_pfac(l2g, t, s1)); }
    }
#undef SC_LOAD
    __syncthreads();
}

__device__ __forceinline__ void scan_phase(LAS unsigned char* l3, const bf16_t* Q, const bf16_t* K, const bf16_t* Vd, bf16_t* GY, const bf16_t* PP, float* ssh, int tid, int bx) {
    const int lane = tid & 63, wid = __builtin_amdgcn_readfirstlane(tid >> 6), dkh = wid >> 2, dvq = wid & 3, r = lane & 15, q4 = lane >> 4;
    const int pair = (bx & 7) * 4 + (bx >> 6), slice = (bx >> 3) & 7, b = pair >> 2, h = pair & 3;
    const float l2g = ret_l2g(h), sdec = exp2f(l2g * 64.f);
    const int ft = tid >> 3, fd8 = (tid & 7) * 8;
    const float qdec = exp2f(l2g * (float)(ft + 1));
    f32x4 S[8];
#pragma unroll
    for (int i = 0; i < 8; ++i) S[i] = (f32x4){0.f, 0.f, 0.f, 0.f};
    const bf16_t* qg = Q + (size_t)b * SEQ * 1024 + h * 256; const bf16_t* kg = K + (size_t)b * SEQ * 1024 + h * 256;
    const bf16_t* vg = Vd + (size_t)b * SEQ * 2048 + h * 512 + slice * 64; bf16_t* gg = GY + (size_t)b * SEQ * 2048 + h * 512 + slice * 64;
    const bf16_t* pg = PP + (size_t)((b * 4 + h) * 64) * 4096;
    float* ssp = ssh + (size_t)h * 8 + slice;
    u32x4 rqX[4], rkX[4], rvX, rpX, rgX, rqY[4], rkY[4], rvY, rpY, rgY;
#define RET_LOADK(rk, c) do { const size_t r0_ = (size_t)(c) * CH; \
        _Pragma("unroll") for (int i = 0; i < 4; ++i) { const int p_ = tid + 512 * i, rw_ = p_ >> 5, c8_ = (p_ & 31) * 8; rk[i] = *(const u32x4*)(kg + (r0_ + rw_) * 1024 + c8_); } } while (0)
#define RET_LOADQ(rq, rv, rp, c) do { const size_t r0_ = (size_t)(c) * CH; \
        _Pragma("unroll") for (int i = 0; i < 4; ++i) { const int p_ = tid + 512 * i, rw_ = p_ >> 5, c8_ = (p_ & 31) * 8; rq[i] = *(const u32x4*)(qg + (r0_ + rw_) * 1024 + c8_); } \
        rv = *(const u32x4*)(vg + (r0_ + ft) * 2048 + fd8); rp = *(const u32x4*)(pg + (size_t)(c) * 4096 + ft * 64 + fd8); } while (0)
#define RET_LOADG(rg, c) do { rg = *(const u32x4*)(gg + ((size_t)(c) * CH + ft) * 2048 + fd8); } while (0)
#define RET_STK(rk) do { _Pragma("unroll") for (int i = 0; i < 4; ++i) { const int p_ = tid + 512 * i, rw_ = p_ >> 5, c8_ = (p_ & 31) * 8; *(LAS u32x4*)(l3 + L_KS + rw_ * KSP + ((c8_ * 2) ^ (((rw_ >> 3) & 1) << 7))) = rk[i]; } } while (0)
#define RET_STQ(rq, rv, rp) do { _Pragma("unroll") for (int i = 0; i < 4; ++i) { const int p_ = tid + 512 * i, rw_ = p_ >> 5, c8_ = (p_ & 31) * 8; *(LAS u32x4*)(l3 + L_QS + rw_ * QP + c8_ * 2) = rq[i]; } \
        *(LAS u32x4*)(l3 + L_VS + ft * VP + fd8 * 2) = rv; *(LAS u32x4*)(l3 + L_PS + ft * VP + fd8 * 2) = rp; } while (0)
#define RET_CHUNK(c, rkC, rgC, rqN, rvN, rpN) do { \
          \
        RET_STK(rkC); RET_LOADK(rkC, ((c) + 2 < NCH ? (c) + 2 : NCH - 1)); \
        bf16x8 vb[2]; \
        _Pragma("unroll") for (int ks = 0; ks < 2; ++ks) { LAS const unsigned char* vp = l3 + L_VS + (32 * ks + 8 * q4 + (r >> 2)) * VP + (16 * dvq + 4 * (r & 3)) * 2; \
            vb[ks] = cat8(trrd(vp), trrd(vp + 4 * VP)); } \
        f32x4 O[4]; \
        _Pragma("unroll") for (int t4 = 0; t4 < 4; ++t4) { const bf16x8 a = *(LAS const bf16x8*)(l3 + L_PS + (16 * t4 + r) * VP + (32 * dkh + 8 * q4) * 2); \
            O[t4] = __builtin_amdgcn_mfma_f32_16x16x32_bf16(a, dkh ? vb[1] : vb[0], (f32x4){0.f, 0.f, 0.f, 0.f}, 0, 0, 0); } \
        _Pragma("unroll") for (int m = 0; m < 4; ++m) { \
            u32x4 sw; sw.x = pk2(S[2 * m][0], S[2 * m][1]); sw.y = pk2(S[2 * m][2], S[2 * m][3]); sw.z = pk2(S[2 * m + 1][0], S[2 * m + 1][1]); sw.w = pk2(S[2 * m + 1][2], S[2 * m + 1][3]); \
            const bf16x8 sb = __builtin_bit_cast(bf16x8, sw); \
            _Pragma("unroll") for (int t4 = 0; t4 < 4; ++t4) { const bf16x8 aq = *(LAS const bf16x8*)(l3 + L_QS + (16 * t4 + r) * QP + (128 * dkh + 32 * m + 8 * q4) * 2); \
                O[t4] = __builtin_amdgcn_mfma_f32_16x16x32_bf16(aq, sb, O[t4], 0, 0, 0); } \
        } \
        { LAS float* os = (LAS float*)(l3 + (dkh ? L_OS1 : L_OS0)); \
          _Pragma("unroll") for (int t4 = 0; t4 < 4; ++t4) _Pragma("unroll") for (int g = 0; g < 4; ++g) os[(16 * t4 + 4 * q4 + g) * OSP + 16 * dvq + r] = O[t4][g]; } \
        __syncthreads(); \
          \
        _Pragma("unroll") for (int i = 0; i < 8; ++i) { \
            S[i] = S[i] * sdec; \
            _Pragma("unroll") for (int ks = 0; ks < 2; ++ks) { LAS const unsigned char* kp = l3 + L_KS + (32 * ks + 8 * q4 + (r >> 2)) * KSP + (((128 * dkh + 16 * i + 4 * (r & 3)) * 2) ^ ((q4 & 1) << 7)); \
                S[i] = __builtin_amdgcn_mfma_f32_16x16x32_bf16(cat8(trrd(kp), trrd(kp + 4 * KSP)), vb[ks], S[i], 0, 0, 0); } \
        } \
        { const LAS float* o0 = (const LAS float*)(l3 + L_OS0) + ft * OSP + fd8; const LAS float* o1 = (const LAS float*)(l3 + L_OS1) + ft * OSP + fd8; \
          const f32x4 a0 = *(const LAS f32x4*)o0, a1 = *(const LAS f32x4*)(o0 + 4), b0 = *(const LAS f32x4*)o1, b1 = *(const LAS f32x4*)(o1 + 4); \
          const f32x4 x0 = (a0 + b0) * qdec, x1 = (a1 + b1) * qdec; \
          float part = (x0[0] * x0[0] + x0[1] * x0[1]) + (x0[2] * x0[2] + x0[3] * x0[3]) + (x1[0] * x1[0] + x1[1] * x1[1]) + (x1[2] * x1[2] + x1[3] * x1[3]); \
          part = addx<1>(part); part = addx<2>(part); part = addx<4>(part); \
          const size_t grow = (size_t)b * SEQ + (size_t)(c) * CH + ft; \
          if ((tid & 7) == 0) ssp[grow * 32] = part;                 \
          u32x4 w; w.x = pk2(bflo(rgC.x) * x0[0], bfhi(rgC.x) * x0[1]); w.y = pk2(bflo(rgC.y) * x0[2], bfhi(rgC.y) * x0[3]); \
          w.z = pk2(bflo(rgC.z) * x1[0], bfhi(rgC.z) * x1[1]); w.w = pk2(bflo(rgC.w) * x1[2], bfhi(rgC.w) * x1[3]); \
          *(u32x4*)(gg + ((size_t)(c) * CH + ft) * 2048 + fd8) = w; \
          RET_LOADG(rgC, ((c) + 2 < NCH ? (c) + 2 : (c))); } \
        RET_STQ(rqN, rvN, rpN); RET_LOADQ(rqN, rvN, rpN, ((c) + 3 < NCH ? (c) + 3 : NCH - 1)); \
        __syncthreads(); } while (0)
    RET_LOADQ(rqX, rvX, rpX, 0); RET_LOADK(rkX, 0); RET_LOADG(rgX, 0);
    RET_LOADQ(rqY, rvY, rpY, 1); RET_LOADK(rkY, 1); RET_LOADG(rgY, 1);
    RET_STQ(rqX, rvX, rpX); RET_LOADQ(rqX, rvX, rpX, 2);
    __syncthreads();
    for (int c = 0; c < NCH; c += 2) {
        RET_CHUNK(c, rkX, rgX, rqY, rvY, rpY);
        RET_CHUNK(c + 1, rkY, rgY, rqX, rvX, rpX);
    }
#undef RET_CHUNK
#undef RET_LOADK
#undef RET_LOADQ
#undef RET_LOADG
#undef RET_STK
#undef RET_STQ
}
__device__ __forceinline__ void norm_phase(bf16_t* GY, const float* ssh, int tid, int G, int bx) {
    for (size_t i = ((size_t)bx * 512 + tid) * 8; i < (size_t)MTOK * 2048; i += (size_t)G * 512 * 8) {
        const size_t m = i >> 11; const int h = (int)((i & 2047) >> 9);
        const f32x4 q0 = *(const f32x4*)(ssh + (m * 4 + h) * 8), q1 = *(const f32x4*)(ssh + (m * 4 + h) * 8 + 4);
        const float rr = rstd_of(((q0[0] + q0[1]) + (q0[2] + q0[3])) + ((q1[0] + q1[1]) + (q1[2] + q1[3])), 1.f / 512.f);
        const u32x4 y = *(const u32x4*)(GY + i); u32x4 w;
        w.x = pk2(bflo(y.x) * rr, bfhi(y.x) * rr); w.y = pk2(bflo(y.y) * rr, bfhi(y.y) * rr); w.z = pk2(bflo(y.z) * rr, bfhi(y.z) * rr); w.w = pk2(bflo(y.w) * rr, bfhi(y.w) * rr);
        *(u32x4*)(GY + i) = w;
    }
}
}


namespace att {
typedef float f32x16 __attribute__((ext_vector_type(16)));
constexpr int KP = 144;
constexpr int VPA = 192;
constexpr int L_K = 0, L_V = 4 * 64 * KP, L_TB = 4 * 64 * KP + 4 * 64 * VPA, TBN = 384;
__device__ __forceinline__ void attention_phase(LAS unsigned char* l3, const bf16_t* Q2, const bf16_t* K2, const bf16_t* V2, const float* rel_bias, const float* qgain, const float* kgain, bf16_t* O2, int tid, int bx) {
    const int lane = tid & 63, wid = __builtin_amdgcn_readfirstlane(tid >> 6), r32 = lane & 31, hi = lane >> 5;
    const int b = bx & 7, h = bx >> 4, c4base = ((bx >> 3) & 1) * 8;
    LAS float* TB = (LAS float*)(l3 + L_TB);
    float gq = fabsf(qgain[lane]), gk = fabsf(kgain[lane]), bm = -1e30f;
    for (int j = lane; j < RELT; j += 64) bm = fmaxf(bm, rel_bias[h * RELT + j]);
#define ATT_WMAX(x) do { x = maxx<1>(x); x = maxx<2>(x); x = maxx<4>(x); x = maxx<8>(x); x = maxx<16>(x); x = maxx<32>(x); } while (0)
    ATT_WMAX(gq); ATT_WMAX(gk); ATT_WMAX(bm);
#undef ATT_WMAX
    const float shift = LOG2E * (8.08f * gq * gk + bm);
    __syncthreads();
    for (int u = tid; u < TBN; u += 512) { const int dist = u - 63; TB[u] = rel_bias[h * RELT + (dist > RELCLIP ? RELCLIP : dist) + RELCLIP] * LOG2E - shift; }
    const float cfar = rel_bias[h * RELT + 2 * RELCLIP] * LOG2E - shift;
    __syncthreads();
    const int sr = tid >> 3, sc8 = (tid & 7) * 8;
    const int qi_l = wid >> 1;
    const int qr = 32 * (wid & 1) + r32;
    const int i16 = lane & 15, g4 = lane >> 4;
    for (int ui = 0; ui < 8; ++ui) {
        const int c4 = c4base + ui, qi = 4 * c4 + qi_l;
        const int kc_lo = (4 * c4 - PAST) < 0 ? 0 : 4 * c4 - PAST, npairs = (4 * c4 + 4 - kc_lo) >> 1;
        const size_t qrow = (size_t)b * SEQ + (size_t)qi * CH + qr;
        bf16x8 qf[4];
#pragma unroll
        for (int ks = 0; ks < 4; ++ks) qf[ks] = *(const bf16x8*)(Q2 + qrow * 1024 + h * 64 + 16 * ks + 8 * hi);
        f32x16 o0, o1; float lsum = 0.f;
#pragma unroll
        for (int g = 0; g < 16; ++g) { o0[g] = 0.f; o1[g] = 0.f; }
        const bf16_t* kbase = K2 + (size_t)b * SEQ * 1024 + h * 64 + (size_t)sr * 1024 + sc8;
        const bf16_t* vbase = V2 + (size_t)b * SEQ * 1024 + h * 64 + (size_t)sr * 1024 + sc8;
        u32x4 rk[2], rv[2];
#pragma unroll
        for (int t = 0; t < 2; ++t) { rk[t] = *(const u32x4*)(kbase + (size_t)(kc_lo + t) * CH * 1024); rv[t] = *(const u32x4*)(vbase + (size_t)(kc_lo + t) * CH * 1024); }
        for (int kp = 0; kp < npairs; ++kp) {
            const int pbo = (kp & 1) * 2 * 64 * KP, pbv = (kp & 1) * 2 * 64 * VPA;
#pragma unroll
            for (int t = 0; t < 2; ++t) { *(LAS u32x4*)(l3 + L_K + pbo + t * 64 * KP + sr * KP + sc8 * 2) = rk[t]; *(LAS u32x4*)(l3 + L_V + pbv + t * 64 * VPA + sr * VPA + sc8 * 2) = rv[t]; }
            { const int kn = kc_lo + 2 * ((kp + 1 < npairs) ? kp + 1 : kp);
#pragma unroll
              for (int t = 0; t < 2; ++t) { rk[t] = *(const u32x4*)(kbase + (size_t)(kn + t) * CH * 1024); rv[t] = *(const u32x4*)(vbase + (size_t)(kn + t) * CH * 1024); } }
            __syncthreads();
            const int dcA = qi - (kc_lo + 2 * kp), dcB = dcA - 1;
            const bool actA = dcA >= 0 && dcA <= PAST, actB = dcB >= 0 && dcB <= PAST;
            if (actA || actB) {
                f32x16 p[2][2];
#pragma unroll
                for (int t = 0; t < 2; ++t) {
                    const int dc = t ? dcB : dcA; const bool act = t ? actB : actA;
                    if (act && dc <= 4) {
                        const LAS float* tb = TB + (64 * dc + qr + 63 - 4 * hi - 59);
#pragma unroll
                        for (int g = 0; g < 16; ++g) { p[t][0][g] = tb[59 - ((g & 3) + 8 * (g >> 2))]; p[t][1][g] = tb[59 - (32 + (g & 3) + 8 * (g >> 2))]; }
                    } else {
                        const float cv = act ? cfar : -INFINITY;
#pragma unroll
                        for (int g = 0; g < 16; ++g) { p[t][0][g] = cv; p[t][1][g] = cv; }
                    }
                }
#pragma unroll
                for (int t = 0; t < 2; ++t) {
                    LAS const unsigned char* kb = l3 + L_K + pbo + t * 64 * KP;
#pragma unroll
                    for (int ks = 0; ks < 4; ++ks) {
                        const bf16x8 k0 = *(LAS const bf16x8*)(kb + r32 * KP + (16 * ks + 8 * hi) * 2), k1 = *(LAS const bf16x8*)(kb + (32 + r32) * KP + (16 * ks + 8 * hi) * 2);
                        p[t][0] = __builtin_amdgcn_mfma_f32_32x32x16_bf16(k0, qf[ks], p[t][0], 0, 0, 0);
                        p[t][1] = __builtin_amdgcn_mfma_f32_32x32x16_bf16(k1, qf[ks], p[t][1], 0, 0, 0);
                    }
                }
#pragma unroll
                for (int t = 0; t < 2; ++t) {
                    float ls = 0.f;
#pragma unroll
                    for (int g = 0; g < 16; ++g) { p[t][0][g] = __builtin_amdgcn_exp2f(p[t][0][g]); p[t][1][g] = __builtin_amdgcn_exp2f(p[t][1][g]); ls += p[t][0][g] + p[t][1][g]; }
                    lsum += ls;
                    bf16x8 pf[2][2];
#pragma unroll
                    for (int n = 0; n < 2; ++n)
#pragma unroll
                        for (int s2 = 0; s2 < 2; ++s2) { u32x4 w; w.x = pk2(p[t][n][8 * s2 + 0], p[t][n][8 * s2 + 1]); w.y = pk2(p[t][n][8 * s2 + 2], p[t][n][8 * s2 + 3]);
                            w.z = pk2(p[t][n][8 * s2 + 4], p[t][n][8 * s2 + 5]); w.w = pk2(p[t][n][8 * s2 + 6], p[t][n][8 * s2 + 7]); pf[n][s2] = __builtin_bit_cast(bf16x8, w); }
                    LAS const unsigned char* vp = l3 + L_V + pbv + t * 64 * VPA + (4 * (g4 >> 1) + (i16 >> 2)) * VPA + (16 * (g4 & 1) + 4 * (i16 & 3)) * 2;
#pragma unroll
                    for (int n = 0; n < 2; ++n)
#pragma unroll
                        for (int s2 = 0; s2 < 2; ++s2) {
                            LAS const unsigned char* vq = vp + (32 * n + 16 * s2) * VPA;
                            const bf16x8 a0 = ret::cat8(ret::trrd(vq), ret::trrd(vq + 8 * VPA)), a1 = ret::cat8(ret::trrd(vq + 64), ret::trrd(vq + 8 * VPA + 64));
                            o0 = __builtin_amdgcn_mfma_f32_32x32x16_bf16(a0, pf[n][s2], o0, 0, 0, 0);
                            o1 = __builtin_amdgcn_mfma_f32_32x32x16_bf16(a1, pf[n][s2], o1, 0, 0, 0);
                        }
                }
            }
        }
        lsum = addx<32>(lsum);
        const float il = 1.0f / lsum;
        bf16_t* op = O2 + qrow * 1024 + h * 64 + 4 * hi;
#pragma unroll
        for (int k4 = 0; k4 < 4; ++k4) {
            u32x2 w; w.x = pk2(o0[4 * k4] * il, o0[4 * k4 + 1] * il); w.y = pk2(o0[4 * k4 + 2] * il, o0[4 * k4 + 3] * il); *(u32x2*)(op + 8 * k4) = w;
            u32x2 z; z.x = pk2(o1[4 * k4] * il, o1[4 * k4 + 1] * il); z.y = pk2(o1[4 * k4 + 2] * il, o1[4 * k4 + 3] * il); *(u32x2*)(op + 32 + 8 * k4) = z;
        }
        __syncthreads();
    }
}
}

__device__ __forceinline__ int phase_tid(int wave) { int ln_; asm volatile("v_mbcnt_lo_u32_b32 %0, -1, 0\n\tv_mbcnt_hi_u32_b32 %0, -1, %0" : "=v"(ln_)); return wave * 64 + ln_; }
constexpr int NPH = 13;
constexpr int CW_BAR = 4096;
constexpr int RING_BYTES = 131072, LDSCTL_OFF = RING_BYTES, MISC_OFF = LDSCTL_OFF + 320, LDS_BYTES = 147456;
struct MArgs { Ptrs P; };
typedef const __attribute__((address_space(4))) Ptrs* KPtrs;
#if defined(PROBE_MASK)
#define PROBE_STAMP(k) do { if (threadIdx.x == 0) ((volatile LAS unsigned*)(l3 + MISC_OFF + 64))[(k) + 1] = (unsigned)__builtin_amdgcn_s_memrealtime(); } while (0)
#else
#define PROBE_STAMP(k) do { } while (0)
#endif
#define PHASE_BEGIN { KPtrs kq = kp0; asm volatile("" : "+s"(kq)); unsigned char* const ws = kq->ws; float* const outp = kq->out; (void)outp; \
        int bxl = (int)blockIdx.x; asm volatile("" : "+s"(bxl)); const int tl = phase_tid(wave); (void)tl; (void)bxl;
#define PHASE_END(k) } xcd_barrier(bar); PROBE_STAMP(k);
#define BFW(off) ((bf16_t*)(ws + (off)))
#define F32W(off) ((float*)(ws + (off)))
template <class Epi> __device__ __forceinline__ void gemm_run(LAS unsigned char* l3, const bf16_t* A, const bf16_t* Bt, int N, int K, const Epi& E, int tl, int bxl) {
    pg8::Gemm g{A, Bt, MTOK, N, K}; pg8::StaticOrder S; S.init(MTOK, N, 256, bxl);
    pg8::gemm_phase<Epi, pg8::StaticOrder, true, true>(l3, g, S, E, tl);
}
__global__ void __launch_bounds__(512, 2) mega(MArgs a_unused) {
    extern __shared__ __attribute__((aligned(16))) unsigned char lds[];
    LAS unsigned char* l3 = (LAS unsigned char*)lds;
    volatile LAS unsigned* MISC = (volatile LAS unsigned*)(l3 + MISC_OFF);
    const int wave = __builtin_amdgcn_readfirstlane((int)threadIdx.x >> 6);
    const KPtrs kp0 = (KPtrs)__builtin_amdgcn_kernarg_segment_ptr();
    for (int u = threadIdx.x; u < (LDS_BYTES - LDSCTL_OFF) / 4; u += 512) ((LAS unsigned*)(l3 + LDSCTL_OFF))[u] = 0u;
    __syncthreads();
    const XcdBarrier bar = xcd_barrier_post((unsigned*)(kp0->ws + WS_CTL) + CW_BAR, MISC + 8);
#if defined(PROBE_MASK)
    if (threadIdx.x == 0) ((volatile LAS unsigned*)(l3 + MISC_OFF + 64))[0] = (unsigned)__builtin_amdgcn_s_memrealtime();
#endif
    PHASE_BEGIN { Ptrs P; P.x = kq->x; P.a_norm_g = kq->a_norm_g; P.a_w_in = kq->a_w_in; P.a_gn_g = kq->a_gn_g; P.a_w_o = kq->a_w_o; P.a_ffn_norm_g = kq->a_ffn_norm_g; P.a_w_gu = kq->a_w_gu; P.a_w_down = kq->a_w_down;
        P.kv_norm_g = kq->kv_norm_g; P.w_kv = kq->w_kv; P.k_norm_g = kq->k_norm_g; P.b_norm_g = kq->b_norm_g; P.b_w_q = kq->b_w_q; P.b_q_norm_g = kq->b_q_norm_g; P.b_rel_bias = kq->b_rel_bias; P.b_w_o = kq->b_w_o;
        P.b_ffn_norm_g = kq->b_ffn_norm_g; P.b_w_gu = kq->b_w_gu; P.b_w_down = kq->b_w_down; P.out = outp; P.ws = ws;
        prologue_phase(P, (float*)(lds + wave * 16384), bxl * 8 + wave, 256 * 8, tl & 63); } PHASE_END(0)
    PHASE_BEGIN { EpiIn E{F32W(WS_SS0), (const unsigned*)(ws + WS_COS), BFW(WS_Q), BFW(WS_K), BFW(WS_V), BFW(WS_G)};
        gemm_run(l3, (const bf16_t*)outp, BFW(WS_W1), RIN, 1024, E, tl, bxl); } PHASE_END(1)
    PHASE_BEGIN ret::scores_phase(l3, BFW(WS_Q), BFW(WS_K), (bf16_t*)outp + (size_t)32 * MiB, tl, 256, bxl); PHASE_END(2)
    PHASE_BEGIN ret::scan_phase(l3, BFW(WS_Q), BFW(WS_K), BFW(WS_V), BFW(WS_G), (const bf16_t*)outp + (size_t)32 * MiB, F32W(WS_SSH), tl, bxl); PHASE_END(3)
    PROBE_STAMP(4);
    PHASE_BEGIN { EpiRes<true> E{kq->x, nullptr, nullptr, BFW(WS_XH1), F32W(WS_SS1), F32W(WS_SSH)}; gemm_run(l3, BFW(WS_G), BFW(WS_W2), 1024, 2048, E, tl, bxl); } PHASE_END(5)
    PHASE_BEGIN { EpiGU E{F32W(WS_SS1), BFW(WS_H)}; gemm_run(l3, BFW(WS_XH1), BFW(WS_W3), 2 * FF, 1024, E, tl, bxl); } PHASE_END(6)
    PHASE_BEGIN { EpiRes<false> E{nullptr, BFW(WS_XH1), nullptr, BFW(WS_XH2), F32W(WS_SS2), nullptr}; gemm_run(l3, BFW(WS_H), BFW(WS_W4), 1024, FF, E, tl, bxl); } PHASE_END(7)
    PHASE_BEGIN { EpiKVQ E{F32W(WS_SS2), kq->k_norm_g, kq->b_q_norm_g, BFW(WS_K2), BFW(WS_V2), BFW(WS_Q2)}; gemm_run(l3, BFW(WS_XH2), BFW(WS_W5), 3072, 1024, E, tl, bxl); } PHASE_END(8)
    PHASE_BEGIN att::attention_phase(l3, BFW(WS_Q2), BFW(WS_K2), BFW(WS_V2), kq->b_rel_bias, kq->b_q_norm_g, kq->k_norm_g, BFW(WS_O2), tl, bxl); PHASE_END(9)
    PHASE_BEGIN { EpiRes<false> E{nullptr, BFW(WS_XH2), nullptr, BFW(WS_XH3), F32W(WS_SS3), nullptr}; gemm_run(l3, BFW(WS_O2), BFW(WS_W6), 1024, 1024, E, tl, bxl); } PHASE_END(10)
    PHASE_BEGIN { EpiGU E{F32W(WS_SS3), BFW(WS_H)}; gemm_run(l3, BFW(WS_XH3), BFW(WS_W7), 2 * FF, 1024, E, tl, bxl); } PHASE_END(11)
    PHASE_BEGIN { EpiRes<false> E{nullptr, BFW(WS_XH3), outp, nullptr, nullptr, nullptr}; gemm_run(l3, BFW(WS_H), BFW(WS_W8), 1024, FF, E, tl, bxl); } } PROBE_STAMP(12);
#if defined(PROBE_MASK)
    if (blockIdx.x == 0 && threadIdx.x == 0) { volatile LAS unsigned* ts_ = (volatile LAS unsigned*)(l3 + MISC_OFF + 64); unsigned acc_ = 0u;
        for (int k = 0; k < NPH; ++k) if ((PROBE_MASK >> k) & 1) acc_ += ts_[k + 1] - ts_[k];
        const unsigned t_end = (unsigned)__builtin_amdgcn_s_memrealtime(); while ((unsigned)__builtin_amdgcn_s_memrealtime() - t_end < acc_) __builtin_amdgcn_s_sleep(8); }
#endif
}
extern "C" void kernel_launch(void* const* d_in, const int* in_sizes, int n_in, void* d_out, int out_size, void* d_ws, size_t ws_size, hipStream_t stream) {
    if (n_in != 19 || ws_size < WS_END || out_size != MTOK * DM) { fprintf(stderr, "kernel_launch: unexpected shapes (n_in %d, ws %zu, out %d)\n", n_in, ws_size, out_size); return; }
    MArgs a{};
    const float** pp = (const float**)&a.P;
    for (int i = 0; i < 19; ++i) pp[i] = (const float*)d_in[i];
    a.P.out = (float*)d_out; a.P.ws = (unsigned char*)d_ws;
    static int grid = 0;
    if (!grid) {
        if (hipFuncSetAttribute((const void*)mega, hipFuncAttributeMaxDynamicSharedMemorySize, LDS_BYTES) != hipSuccess) fprintf(stderr, "kernel_launch: hipFuncSetAttribute(mega) failed\n");
        int dev = 0, cus = 0, per_cu = 0; (void)hipGetDevice(&dev); (void)hipDeviceGetAttribute(&cus, hipDeviceAttributeMultiprocessorCount, dev);
        (void)hipOccupancyMaxActiveBlocksPerMultiprocessor(&per_cu, (const void*)mega, 512, LDS_BYTES);
        if (per_cu < 1 || cus < 256) fprintf(stderr, "kernel_launch: built for 256 CUs with one 512-thread workgroup each (device: %d CUs, occupancy query %d per CU)\n", cus, per_cu);
        (void)hipGetLastError();
        grid = 256;
    }
    (void)hipMemsetAsync(d_ws, 0, ZERO_BYTES, stream);
    void* args[] = {(void*)&a};
    if (hipLaunchCooperativeKernel((const void*)mega, dim3(grid), dim3(512), args, LDS_BYTES, stream) != hipSuccess) {
        (void)hipGetLastError(); fprintf(stderr, "kernel_launch: cooperative launch refused; plain launch of the same grid\n");
        hipLaunchKernelGGL(mega, dim3(grid), dim3(512), LDS_BYTES, stream, a);
    }
    const hipError_t e = hipPeekAtLastError();
    if (e != hipSuccess) fprintf(stderr, "kernel_launch: launch failed: %s\n", hipGetErrorName(e));
}
```

```cpp
#include <hip/hip_runtime.h>
#include <cstdio>
#include <cstdint>
#include <type_traits>

typedef unsigned short bf16_t;
typedef short bf16x8 __attribute__((ext_vector_type(8)));
typedef float f32x4 __attribute__((ext_vector_type(4)));
typedef float f32x2 __attribute__((ext_vector_type(2)));
typedef unsigned u32x4 __attribute__((ext_vector_type(4)));
typedef unsigned u32x2 __attribute__((ext_vector_type(2)));

constexpr int BATCH = 8, SEQ = 4096, DM = 1024, MTOK = BATCH * SEQ;
constexpr int CH = 64, NCH = SEQ / CH;
constexpr int RH = 4, RDK = 256, RDV = 512, RQC = 1024, RVC = 2048, RIN = 6144;
constexpr int AH = 16, AHD = 64, PAST = 8, RELCLIP = 256, RELT = 513;
constexpr int FF = 2816;
constexpr float EPS = 1e-6f;
constexpr float LOG2E = 1.4426950408889634f;

constexpr size_t MiB = 1u << 20;
constexpr size_t WS_CTL = 0;
constexpr size_t WS_SS1 = 1 * MiB;
constexpr size_t WS_SS2 = WS_SS1 + 128 * 1024;
constexpr size_t WS_SS3 = WS_SS2 + 128 * 1024;
constexpr size_t WS_SSH = 66 * MiB;
constexpr size_t ZERO_BYTES = 2 * MiB;
constexpr size_t WS_SS0 = 2 * MiB;
constexpr size_t WS_COS = 3 * MiB;
constexpr size_t WS_W1 = 8 * MiB, WS_W2 = 20 * MiB, WS_W3 = 24 * MiB, WS_W4 = 35 * MiB, WS_W5 = 41 * MiB, WS_W6 = 47 * MiB, WS_W7 = 49 * MiB, WS_W8 = 60 * MiB;
constexpr size_t WS_Q = 72 * MiB, WS_K = 136 * MiB, WS_V = 200 * MiB, WS_G = 328 * MiB;
constexpr size_t WS_XH1 = 248 * MiB, WS_H = 72 * MiB, WS_XH2 = 328 * MiB;
constexpr size_t WS_K2 = 72 * MiB, WS_V2 = 136 * MiB, WS_Q2 = 200 * MiB, WS_O2 = 264 * MiB, WS_XH3 = 392 * MiB;
constexpr size_t WS_END = 456 * MiB;

struct Ptrs {
    const float *x, *a_norm_g, *a_w_in, *a_gn_g, *a_w_o, *a_ffn_norm_g, *a_w_gu, *a_w_down, *kv_norm_g, *w_kv, *k_norm_g,
                *b_norm_g, *b_w_q, *b_q_norm_g, *b_rel_bias, *b_w_o, *b_ffn_norm_g, *b_w_gu, *b_w_down;
    float* out; unsigned char* ws;
};

__device__ __forceinline__ unsigned f2bf(float f) { unsigned u = __float_as_uint(f); return (u + 0x7fffu + ((u >> 16) & 1u)) >> 16; }
typedef __bf16 bf16x2_t __attribute__((ext_vector_type(2)));
__device__ __forceinline__ unsigned pk2(float lo, float hi) { const f32x2 v = {lo, hi}; const bf16x2_t b = __builtin_convertvector(v, bf16x2_t); return __builtin_bit_cast(unsigned, b); }
__device__ __forceinline__ float bf2f(unsigned short h) { return __uint_as_float((unsigned)h << 16); }
__device__ __forceinline__ float bflo(unsigned w) { return __uint_as_float(w << 16); }
__device__ __forceinline__ float bfhi(unsigned w) { return __uint_as_float(w & 0xffff0000u); }
__device__ __forceinline__ void store8bf(bf16_t* dst, const f32x4 a, const f32x4 b) {
    u32x4 w; w.x = pk2(a[0], a[1]); w.y = pk2(a[2], a[3]); w.z = pk2(b[0], b[1]); w.w = pk2(b[2], b[3]); *(u32x4*)dst = w;
}
template <int MASK> __device__ __forceinline__ float shx(float v) {
    if constexpr (MASK == 32) { const auto r = __builtin_amdgcn_permlane32_swap(__float_as_uint(v), __float_as_uint(v), false, false); return __uint_as_float((threadIdx.x & 32) ? r[0] : r[1]); }
    else return __uint_as_float((unsigned)__builtin_amdgcn_ds_swizzle((int)__float_as_uint(v), 0x1f | (MASK << 10)));
}
template <int MASK> __device__ __forceinline__ float addx(float v) {
    if constexpr (MASK == 32) { const auto r = __builtin_amdgcn_permlane32_swap(__float_as_uint(v), __float_as_uint(v), false, false); return __uint_as_float(r[0]) + __uint_as_float(r[1]); }
    else return v + shx<MASK>(v);
}
template <int MASK> __device__ __forceinline__ float maxx(float v) {
    if constexpr (MASK == 32) { const auto r = __builtin_amdgcn_permlane32_swap(__float_as_uint(v), __float_as_uint(v), false, false); return fmaxf(__uint_as_float(r[0]), __uint_as_float(r[1])); }
    else return fmaxf(v, shx<MASK>(v));
}
__device__ __forceinline__ float rstd_of(float ss, float inv_n) { return __builtin_amdgcn_rsqf(ss * inv_n + EPS); }
__device__ __forceinline__ float silu_f(float g) { return g * __builtin_amdgcn_rcpf(1.f + __builtin_amdgcn_exp2f(-LOG2E * g)); }

enum { MAP_ID = 0, MAP_WIN = 1, MAP_GU = 2, MAP_HEAD = 3 };
struct TrItem { const float* W; int K, Nsrc; bf16_t* WT; int dst_row_off; const float* gain; int map, src_off, Ndst, item; };
__device__ __forceinline__ TrItem tr_decode(const Ptrs& P, int it) {
    unsigned char* ws = P.ws;
    constexpr int I1 = 16 * 192, I2 = 32 * 32, I3 = 16 * 176, I4 = 44 * 32, I5 = 16 * 32, I6 = 16 * 32;
    int r = it;
    if (r < I1) return TrItem{P.a_w_in, 1024, RIN, (bf16_t*)(ws + WS_W1), 0, P.a_norm_g, MAP_WIN, 0, RIN, r}; r -= I1;
    if (r < I2) return TrItem{P.a_w_o, 2048, 1024, (bf16_t*)(ws + WS_W2), 0, P.a_gn_g, MAP_ID, 0, 1024, r}; r -= I2;
    if (r < I3) return TrItem{P.a_w_gu, 1024, 2 * FF, (bf16_t*)(ws + WS_W3), 0, P.a_ffn_norm_g, MAP_GU, 0, 2 * FF, r}; r -= I3;
    if (r < I4) return TrItem{P.a_w_down, FF, 1024, (bf16_t*)(ws + WS_W4), 0, nullptr, MAP_ID, 0, 1024, r}; r -= I4;
    if (r < I5) return TrItem{P.w_kv, 1024, 2048, (bf16_t*)(ws + WS_W5), 0, P.kv_norm_g, MAP_HEAD, 0, 1024, r}; r -= I5;
    if (r < I5) return TrItem{P.w_kv, 1024, 2048, (bf16_t*)(ws + WS_W5), 1024, P.kv_norm_g, MAP_ID, 1024, 1024, r}; r -= I5;
    if (r < I5) return TrItem{P.b_w_q, 1024, 1024, (bf16_t*)(ws + WS_W5), 2048, P.b_norm_g, MAP_HEAD, 0, 1024, r}; r -= I5;
    if (r < I6) return TrItem{P.b_w_o, 1024, 1024, (bf16_t*)(ws + WS_W6), 0, nullptr, MAP_ID, 0, 1024, r}; r -= I6;
    if (r < I3) return TrItem{P.b_w_gu, 1024, 2 * FF, (bf16_t*)(ws + WS_W7), 0, P.b_ffn_norm_g, MAP_GU, 0, 2 * FF, r}; r -= I3;
    return TrItem{P.b_w_down, FF, 1024, (bf16_t*)(ws + WS_W8), 0, nullptr, MAP_ID, 0, 1024, r};
}
__device__ __forceinline__ void tr_load(const TrItem& T, int lane, f32x4 (&wv)[8], float (&gv)[8]) {
    const int nblk = T.Ndst / 32, kb = T.item / nblk, nb = T.item % nblk, k0 = 64 * kb, n0 = 32 * nb;
    int src; float cs = 1.f;
    if (T.map == MAP_GU) { const int pn = n0 >> 8, c = n0 & 255; src = c < 128 ? 128 * pn + c : FF + 128 * pn + (c - 128); }
    else if (T.map == MAP_HEAD) { const int pn = n0 >> 8, c = n0 & 255, bj = c >> 7, wc = (c & 127) >> 5; src = T.src_off + 256 * pn + 64 * wc + 32 * bj; }
    else { src = T.src_off + n0; if (T.map == MAP_WIN && n0 >= 1024 && n0 < 2048) cs = 0.0625f; }
    const int rsub = lane >> 3, c4 = (lane & 7) * 4;
#pragma unroll
    for (int i = 0; i < 8; ++i) { const int kk = 8 * i + rsub; wv[i] = *(const f32x4*)(T.W + (size_t)(k0 + kk) * T.Nsrc + src + c4); gv[i] = T.gain ? T.gain[k0 + kk] * cs : cs; }
}
__device__ __forceinline__ void tr_finish(const TrItem& T, int lane, const f32x4 (&wv)[8], const float (&gv)[8], float* scr) {
    const int nblk = T.Ndst / 32, kb = T.item / nblk, nb = T.item % nblk, k0 = 64 * kb, n0 = 32 * nb;
    { const int rsub = lane >> 3, c4 = (lane & 7) * 4;
#pragma unroll
      for (int i = 0; i < 8; ++i) { float* d = scr + (8 * i + rsub) * 33 + c4; d[0] = wv[i][0] * gv[i]; d[1] = wv[i][1] * gv[i]; d[2] = wv[i][2] * gv[i]; d[3] = wv[i][3] * gv[i]; } }
    __builtin_amdgcn_s_waitcnt(0xc07f); asm volatile("" ::: "memory");
    const int c = lane & 7;
#pragma unroll
    for (int j = 0; j < 4; ++j) { const int n = (lane >> 3) + 8 * j; const float* sp = scr + (8 * c) * 33 + n;
        u32x4 o; o.x = pk2(sp[0 * 33], sp[1 * 33]); o.y = pk2(sp[2 * 33], sp[3 * 33]); o.z = pk2(sp[4 * 33], sp[5 * 33]); o.w = pk2(sp[6 * 33], sp[7 * 33]);
        *(u32x4*)(T.WT + (size_t)(T.dst_row_off + n0 + n) * T.K + k0 + 8 * c) = o; }
    __builtin_amdgcn_s_waitcnt(0xc07f); asm volatile("" ::: "memory");
}
__device__ __forceinline__ float wave_sum(float v) { v = addx<1>(v); v = addx<2>(v); v = addx<4>(v); v = addx<8>(v); v = addx<16>(v); return addx<32>(v); }
__device__ __forceinline__ void prologue_phase(const Ptrs& P, float* scr, int gw, int NGW, int lane) {
    unsigned char* ws = P.ws;
    constexpr int NITEMS = 16 * 192 + 32 * 32 + 2 * (16 * 176) + 2 * (44 * 32) + 3 * (16 * 32) + 16 * 32;
    {   f32x4 wvA[8], wvB[8]; float gvA[8], gvB[8];
        int it = gw;
        if (it < NITEMS) { TrItem TA = tr_decode(P, it); tr_load(TA, lane, wvA, gvA);
            for (;;) {
                const int itB = it + NGW; TrItem TB = tr_decode(P, itB < NITEMS ? itB : it);
                if (itB < NITEMS) tr_load(TB, lane, wvB, gvB);
                tr_finish(TA, lane, wvA, gvA, scr);
                if (itB >= NITEMS) break;
                const int itA = itB + NGW; TA = tr_decode(P, itA < NITEMS ? itA : itB);
                if (itA < NITEMS) tr_load(TA, lane, wvA, gvA);
                tr_finish(TB, lane, wvB, gvB, scr);
                if (itA >= NITEMS) break;
                it = itA;
            } }
    }
    bf16_t* xh0 = (bf16_t*)P.out; float* ss0 = (float*)(ws + WS_SS0);
    {   f32x4 vA[4][4], vB[4][4];
#define XP_LOAD(v, m0) do { _Pragma("unroll") for (int r = 0; r < 4; ++r) { const f32x4* xr = (const f32x4*)(P.x + (size_t)((m0) + r) * DM) + lane; _Pragma("unroll") for (int j = 0; j < 4; ++j) v[r][j] = xr[64 * j]; } } while (0)
#define XP_FIN(v, m0) do { float sq[4]; \
        _Pragma("unroll") for (int r = 0; r < 4; ++r) { float a_ = 0.f; \
            _Pragma("unroll") for (int j = 0; j < 4; ++j) a_ += (v[r][j][0] * v[r][j][0] + v[r][j][1] * v[r][j][1]) + (v[r][j][2] * v[r][j][2] + v[r][j][3] * v[r][j][3]); sq[r] = wave_sum(a_); } \
        _Pragma("unroll") for (int r = 0; r < 4; ++r) { u32x2* o = (u32x2*)(xh0 + (size_t)((m0) + r) * DM) + lane; \
            _Pragma("unroll") for (int j = 0; j < 4; ++j) { u32x2 w; w.x = pk2(v[r][j][0], v[r][j][1]); w.y = pk2(v[r][j][2], v[r][j][3]); o[64 * j] = w; } \
            if (lane == 0) ss0[(m0) + r] = sq[r]; } } while (0)
        const int step = NGW * 4;
        XP_LOAD(vA, gw * 4);
        for (int m0 = gw * 4; m0 < MTOK; m0 += 2 * step) {
            XP_LOAD(vB, m0 + step);
            XP_FIN(vA, m0);
            XP_LOAD(vA, (m0 + 2 * step < MTOK ? m0 + 2 * step : m0));
            XP_FIN(vB, m0 + step);
        }
#undef XP_LOAD
#undef XP_FIN
    }
    unsigned* rcs = (unsigned*)(ws + WS_COS);
    if ((gw & 3) == 0 && (gw >> 2) < 512) {
        const int e = (gw >> 2) * 64 + lane, i = e & 127, pb = e >> 7;
        double th = 1.0; { double bb = 0.9305720409296989792906463164991; int k = i; while (k) { if (k & 1) th *= bb; bb *= bb; k >>= 1; } }
        double c1, s1; { const double t2 = th * th;
            double cs = 1.0 / 2432902008176640000.0; cs = cs * t2 - 1.0 / 6402373705728000.0; cs = cs * t2 + 1.0 / 20922789888000.0; cs = cs * t2 - 1.0 / 87178291200.0; cs = cs * t2 + 1.0 / 479001600.0;
            cs = cs * t2 - 1.0 / 3628800.0; cs = cs * t2 + 1.0 / 40320.0; cs = cs * t2 - 1.0 / 720.0; cs = cs * t2 + 1.0 / 24.0; cs = cs * t2 - 0.5; c1 = cs * t2 + 1.0;
            double sn = 1.0 / 51090942171709440000.0; sn = sn * t2 - 1.0 / 121645100408832000.0; sn = sn * t2 + 1.0 / 355687428096000.0; sn = sn * t2 - 1.0 / 1307674368000.0; sn = sn * t2 + 1.0 / 6227020800.0;
            sn = sn * t2 - 1.0 / 39916800.0; sn = sn * t2 + 1.0 / 362880.0; sn = sn * t2 - 1.0 / 5040.0; sn = sn * t2 + 1.0 / 120.0; sn = sn * t2 - 1.0 / 6.0; s1 = (sn * t2 + 1.0) * th; }
        double cc = 1.0, sc = 0.0; { double bc = c1, bs = s1; int k = 16 * pb;
            while (k) { if (k & 1) { const double nc = cc * bc - sc * bs, ns = cc * bs + sc * bc; cc = nc; sc = ns; }
                const double c2 = bc * bc - bs * bs, s2 = 2.0 * bc * bs; bc = c2; bs = s2; k >>= 1; } }
#pragma unroll 4
        for (int p = 0; p < 16; ++p) { const int pos = pb * 16 + p; const _Float16 hc_ = (_Float16)(float)cc, hs_ = (_Float16)(float)sc;
            rcs[pos * 128 + i] = (unsigned)__builtin_bit_cast(unsigned short, hc_) | ((unsigned)__builtin_bit_cast(unsigned short, hs_) << 16);
            const double nc = cc * c1 - sc * s1, ns = cc * s1 + sc * c1; cc = nc; sc = ns; }
    }
}

__device__ __forceinline__ float ret_l2g(int h) { return h == 0 ? -0.04580368961312479f : h == 1 ? -0.02272007650008353f : h == 2 ? -0.011315313227834146f : -0.005646563141142063f; }
__device__ __forceinline__ float ret_pfac(float l2g, int t, int s) { return exp2f(l2g * (float)(t >= s ? -64 : 2 * (s - t) - 64)); }

#define PG8_LAS_ __attribute__((address_space(3)))
namespace pg8 { struct Unit { int pm, pn; }; }
struct NoLoad {};
struct EpiIn {
    static constexpr bool PERM = true, AFTER_DRAIN = false, KHOOK = false; static constexpr int HB = 4;
    const float* ss; const unsigned* rcs; bf16_t *Q, *K, *V, *G;
    struct Light { float ssv; };
    struct Heavy { u32x4 t0, t1; };
    __device__ __forceinline__ Light lpre(int row, int pn, int wc, int fq) const { Light p; p.ssv = ss[row]; return p; }
    __device__ __forceinline__ Heavy hpre(int row, int pn, int wc, int fq) const {
        Heavy p;
        if (pn < 8) { const int pos = row & (SEQ - 1), c8 = wc * 32 + fq * 8;
            p.t0 = *(const u32x4*)(rcs + pos * 128 + c8); p.t1 = *(const u32x4*)(rcs + pos * 128 + c8 + 4); }
        else { p.t0 = p.t1 = (u32x4){0u, 0u, 0u, 0u}; }
        return p;
    }
    typedef NoLoad UPre;
    __device__ __forceinline__ UPre upre(int pn, int wc, int fq) const { return UPre{}; }
    __device__ __forceinline__ void fin(int row, int pn, int wc, int fq, const f32x4 (&v)[2][2], const Light& l, const Heavy& p, const UPre&) const {
        const float rs = rstd_of(l.ssv, 1.f / 1024.f);
        const int c8 = wc * 32 + fq * 8;
        const f32x4 a0 = v[0][0] * rs, a1 = v[0][1] * rs, b0 = v[1][0] * rs, b1 = v[1][1] * rs;
        struct CS { f32x4 c0, c1, s0, s1; } q;
        if (pn < 8) {
#define H2F(w, hi) ((float)__builtin_bit_cast(_Float16, (unsigned short)((hi) ? ((w) >> 16) : ((w) & 0xffffu))))
            q.c0 = (f32x4){H2F(p.t0.x, 0), H2F(p.t0.y, 0), H2F(p.t0.z, 0), H2F(p.t0.w, 0)}; q.s0 = (f32x4){H2F(p.t0.x, 1), H2F(p.t0.y, 1), H2F(p.t0.z, 1), H2F(p.t0.w, 1)};
            q.c1 = (f32x4){H2F(p.t1.x, 0), H2F(p.t1.y, 0), H2F(p.t1.z, 0), H2F(p.t1.w, 0)}; q.s1 = (f32x4){H2F(p.t1.x, 1), H2F(p.t1.y, 1), H2F(p.t1.z, 1), H2F(p.t1.w, 1)};
#undef H2F
        }
        if (pn < 4) {
            bf16_t* dst = Q + (size_t)row * 1024 + pn * 256 + wc * 32 + 16 * (fq & 1) + 4 * (fq >> 1);
            const f32x4 r0 = a0 * q.c0 - b0 * q.s0, r1 = a1 * q.c1 - b1 * q.s1, i0 = a0 * q.s0 + b0 * q.c0, i1 = a1 * q.s1 + b1 * q.c1;
            u32x2 w; w.x = pk2(r0[0], r0[1]); w.y = pk2(r0[2], r0[3]); *(u32x2*)dst = w; w.x = pk2(r1[0], r1[1]); w.y = pk2(r1[2], r1[3]); *(u32x2*)(dst + 8) = w;
            w.x = pk2(i0[0], i0[1]); w.y = pk2(i0[2], i0[3]); *(u32x2*)(dst + 128) = w; w.x = pk2(i1[0], i1[1]); w.y = pk2(i1[2], i1[3]); *(u32x2*)(dst + 136) = w;
        } else if (pn < 8) {
            bf16_t* dst = K + (size_t)row * 1024 + (pn & 3) * 256 + c8;
            store8bf(dst, a0 * q.c0 - b0 * q.s0, a1 * q.c1 - b1 * q.s1);
            store8bf(dst + 128, a0 * q.s0 + b0 * q.c0, a1 * q.s1 + b1 * q.c1);
        } else if (pn < 16) {
            bf16_t* dst = V + (size_t)row * 2048 + (pn - 8) * 256 + c8;
            const float kd = exp2f(ret_l2g((pn - 8) >> 1) * (float)(63 - (row & 63)));
            store8bf(dst, a0 * kd, a1 * kd); store8bf(dst + 128, b0 * kd, b1 * kd);
        } else {
            bf16_t* dst = G + (size_t)row * 2048 + (pn - 16) * 256 + c8;
            f32x4 g[4] = {a0, a1, b0, b1};
#pragma unroll
            for (int i = 0; i < 4; ++i)
#pragma unroll
                for (int e = 0; e < 4; ++e) g[i][e] = silu_f(g[i][e]);
            store8bf(dst, g[0], g[1]); store8bf(dst + 128, g[2], g[3]);
        }
    }
};
template <bool F32BASE> struct EpiRes {
    static constexpr bool PERM = false, AFTER_DRAIN = false, KHOOK = F32BASE; static constexpr int HB = 4;
    const float* basef; const bf16_t* baseh; float* out; bf16_t* xh; float* ss; const float* ssh;
    static constexpr int TAB_OFF = 131072 + 1024;
    template <class Sched> __device__ __forceinline__ void hook_fill(PG8_LAS_ unsigned char* lds, const Sched& S, int tid) const {
        pg8::Unit u; const int i = tid >> 8, rl = tid & 255;
        if (S.next(i, u)) { const float* p = ssh + (size_t)(u.pm * 256 + rl) * 32; float r[4];
#pragma unroll
            for (int h = 0; h < 4; ++h) { const f32x4 a = *(const f32x4*)(p + 8 * h), b = *(const f32x4*)(p + 8 * h + 4); r[h] = rstd_of(((a[0] + a[1]) + (a[2] + a[3])) + ((b[0] + b[1]) + (b[2] + b[3])), 1.f / 512.f); }
            *(PG8_LAS_ f32x4*)(lds + TAB_OFF + i * 4096 + rl * 16) = (f32x4){r[0] * __builtin_amdgcn_rcpf(r[1]), r[1] * __builtin_amdgcn_rcpf(r[2]), r[2] * __builtin_amdgcn_rcpf(r[3]), r[3]}; }
    }
    __device__ __forceinline__ void hook_scale(f32x4 (&acc)[2][2][4][2], PG8_LAS_ unsigned char* lds, int ui, int idx, int wr) const {
        int l2_; asm volatile("v_mbcnt_lo_u32_b32 %0, -1, 0\n\tv_mbcnt_hi_u32_b32 %0, -1, %0" : "=v"(l2_));
        const PG8_LAS_ float* tb = (const PG8_LAS_ float*)(lds + TAB_OFF + (ui & 1) * 4096) + idx + (wr * 64 + (l2_ & 15)) * 4;
#pragma unroll
        for (int ai = 0; ai < 2; ++ai)
#pragma unroll
            for (int m = 0; m < 4; ++m) { const float rho = tb[(128 * ai + 16 * m) * 4];
#pragma unroll
                for (int bj = 0; bj < 2; ++bj)
#pragma unroll
                    for (int n = 0; n < 2; ++n) acc[ai][bj][m][n] = acc[ai][bj][m][n] * rho; }
    }
    struct LightH { u32x2 b[2][2]; };
    struct HeavyF { f32x4 b[2][2]; };
    typedef typename std::conditional<F32BASE, NoLoad, LightH>::type Light;
    typedef typename std::conditional<F32BASE, HeavyF, NoLoad>::type Heavy;
    __device__ __forceinline__ Light lpre(int row, int pn, int wc, int fq) const {
        Light p;
        if constexpr (!F32BASE) { const size_t off0 = (size_t)row * DM + pn * 256 + wc * 32 + 4 * fq;
#pragma unroll
            for (int bj = 0; bj < 2; ++bj)
#pragma unroll
                for (int n = 0; n < 2; ++n) p.b[bj][n] = *(const u32x2*)(baseh + off0 + bj * 128 + n * 16); }
        return p;
    }
    __device__ __forceinline__ Heavy hpre(int row, int pn, int wc, int fq) const {
        Heavy p;
        if constexpr (F32BASE) { const size_t off0 = (size_t)row * DM + pn * 256 + wc * 32 + 4 * fq;
#pragma unroll
            for (int bj = 0; bj < 2; ++bj)
#pragma unroll
                for (int n = 0; n < 2; ++n) p.b[bj][n] = *(const f32x4*)(basef + off0 + bj * 128 + n * 16); }
        return p;
    }
    typedef NoLoad UPre;
    __device__ __forceinline__ UPre upre(int pn, int wc, int fq) const { return UPre{}; }
    __device__ __forceinline__ void fin(int row, int pn, int wc, int fq, const f32x4 (&v)[2][2], const Light& l, const Heavy& p, const UPre&) const {
        const size_t off0 = (size_t)row * DM + pn * 256 + wc * 32 + 4 * fq; float part = 0.f;
#pragma unroll
        for (int bj = 0; bj < 2; ++bj)
#pragma unroll
            for (int n = 0; n < 2; ++n) { const size_t off = off0 + bj * 128 + n * 16;
                f32x4 bs;
                if constexpr (F32BASE) bs = p.b[bj][n]; else bs = (f32x4){bflo(l.b[bj][n].x), bfhi(l.b[bj][n].x), bflo(l.b[bj][n].y), bfhi(l.b[bj][n].y)};
                const f32x4 x = bs + v[bj][n];
                if (out) *(f32x4*)(out + off) = x;
                if (xh) { u32x2 w; w.x = pk2(x[0], x[1]); w.y = pk2(x[2], x[3]); *(u32x2*)(xh + off) = w; }
                part += (x[0] * x[0] + x[1] * x[1]) + (x[2] * x[2] + x[3] * x[3]); }
        if (ss) { part = addx<16>(part); part = addx<32>(part); if (fq == 0) atomicAdd(ss + row, part); }
    }
};
struct EpiGU {
    static constexpr bool PERM = true, AFTER_DRAIN = false, KHOOK = false; static constexpr int HB = 4;
    const float* ss; bf16_t* H;
    struct Light { float ssv; };
    typedef NoLoad Heavy;
    __device__ __forceinline__ Light lpre(int row, int pn, int wc, int fq) const { Light p; p.ssv = ss[row]; return p; }
    __device__ __forceinline__ Heavy hpre(int row, int pn, int wc, int fq) const { return Heavy{}; }
    typedef NoLoad UPre;
    __device__ __forceinline__ UPre upre(int pn, int wc, int fq) const { return UPre{}; }
    __device__ __forceinline__ void fin(int row, int pn, int wc, int fq, const f32x4 (&v)[2][2], const Light& l, const Heavy&, const UPre&) const {
        const float rs = rstd_of(l.ssv, 1.f / 1024.f);
        f32x4 h[2];
#pragma unroll
        for (int n = 0; n < 2; ++n)
#pragma unroll
            for (int e = 0; e < 4; ++e) { const float g = v[0][n][e] * rs, u = v[1][n][e] * rs; h[n][e] = silu_f(g) * u; }
        store8bf(H + (size_t)row * FF + pn * 128 + wc * 32 + fq * 8, h[0], h[1]);
    }
};
struct EpiKVQ {
    static constexpr bool PERM = true, AFTER_DRAIN = false, KHOOK = false; static constexpr int HB = 4;
    const float* ss; const float* kg; const float* qg; bf16_t *K2, *V2, *Q2;
    struct Light { float ssv; };
    typedef NoLoad Heavy;
    __device__ __forceinline__ Light lpre(int row, int pn, int wc, int fq) const { Light p; p.ssv = ss[row]; return p; }
    __device__ __forceinline__ Heavy hpre(int row, int pn, int wc, int fq) const { return Heavy{}; }
    struct UPre { f32x4 g[2][2]; };
    __device__ __forceinline__ UPre upre(int pn, int wc, int fq) const {
        UPre u; const int t = pn >> 2; const float sc = (t == 2 ? 0.125f * LOG2E : 1.f); const float* gp = (t == 0 ? kg : qg) + fq * 8;
#pragma unroll
        for (int bj = 0; bj < 2; ++bj) { u.g[bj][0] = (t == 1) ? (f32x4){1.f, 1.f, 1.f, 1.f} : *(const f32x4*)(gp + 32 * bj) * sc; u.g[bj][1] = (t == 1) ? (f32x4){1.f, 1.f, 1.f, 1.f} : *(const f32x4*)(gp + 32 * bj + 4) * sc; }
        return u;
    }
    __device__ __forceinline__ void fin(int row, int pn, int wc, int fq, const f32x4 (&v)[2][2], const Light& l, const Heavy&, const UPre& up) const {
        const float rs = rstd_of(l.ssv, 1.f / 1024.f);
        const int t = pn >> 2, pl = pn & 3;
        f32x4 x[2][2]; float s = 0.f;
#pragma unroll
        for (int bj = 0; bj < 2; ++bj)
#pragma unroll
            for (int n = 0; n < 2; ++n) { x[bj][n] = v[bj][n] * rs; s += (x[bj][n][0] * x[bj][n][0] + x[bj][n][1] * x[bj][n][1]) + (x[bj][n][2] * x[bj][n][2] + x[bj][n][3] * x[bj][n][3]); }
        if (t == 1) {
            bf16_t* dst = V2 + (size_t)row * 1024 + pl * 256 + wc * 32 + fq * 8;
            store8bf(dst, x[0][0], x[0][1]); store8bf(dst + 128, x[1][0], x[1][1]);
        } else {
            s = addx<16>(s); s = addx<32>(s);
            const float rh = rstd_of(s, 1.f / 64.f);
            bf16_t* dst = (t == 0 ? K2 : Q2) + (size_t)row * 1024 + (4 * pl + wc) * 64 + fq * 8;
#pragma unroll
            for (int bj = 0; bj < 2; ++bj) store8bf(dst + 32 * bj, x[bj][0] * up.g[bj][0] * rh, x[bj][1] * up.g[bj][1] * rh);
        }
    }
};

namespace pg8 {
#define PG8_LAS __attribute__((address_space(3)))
typedef unsigned short bf16_t;
typedef short bf16x8 __attribute__((ext_vector_type(8)));
typedef float f32x4 __attribute__((ext_vector_type(4)));
typedef unsigned u32x4 __attribute__((ext_vector_type(4)));
constexpr int BM = 256, BK = 64, HALF = 128, HTB = HALF * BK * 2  , STAGE_BYTES = 8 * HTB, NXCD = 8, WGM = 8;

__host__ __device__ __forceinline__ int lds_byte(int r, int c) { const int st = (r >> 4) * 2 + (c >> 5), rr = r & 15, cc = c & 31, ob = rr * 64 + cc * 2; return st * 1024 + (ob ^ (((ob >> 9) & 1) << 5)); }
__host__ __device__ __forceinline__ void stage_rc(int b, int& R, int& C) { const int st = b / 1024, sb = b % 1024, swz = sb ^ (((sb >> 9) & 1) << 5); R = (st >> 1) * 16 + swz / 64; C = (st & 1) * 32 + (swz % 64) / 2; }
__host__ __device__ __forceinline__ int perm32(int rho) { const int n = rho >> 4, i = rho & 15; return 8 * (i >> 2) + 4 * n + (i & 3); }

struct Gemm { const bf16_t* A; const bf16_t* Bt; int M, N, K; };

struct StaticOrder {
    int nM, nN, nwg, G, c;
    __host__ __device__ void init(int M, int N, int G_, int c_) { nM = M / BM; nN = N / BM; nwg = nM * nN; G = G_; c = c_; }
    __host__ __device__ bool next(int i, Unit& u) const {
        const long L = (long)i * G + c; if (L >= nwg) return false;
        int wgid = (int)L; { const int q = nwg / NXCD, r = nwg % NXCD, xcd = wgid % NXCD, off = wgid / NXCD; wgid = (xcd < r ? xcd * (q + 1) : r * (q + 1) + (xcd - r) * q) + off; }
        const int nig = WGM * nN, gid = wgid / nig, fm = gid * WGM, gsz = (nM - fm) < WGM ? (nM - fm) : WGM;
        u.pm = fm + ((wgid % nig) % gsz); u.pn = (wgid % nig) / gsz; return true;
    }
    __device__ __forceinline__ void a_ready(const Unit&) const {}
    __device__ __forceinline__ void done(const Unit&) const {}
};
__device__ __forceinline__ unsigned cvt_pk_bf16(float lo, float hi) { unsigned r; asm volatile("v_cvt_pk_bf16_f32 %0, %1, %2" : "=v"(r) : "v"(lo), "v"(hi)); return r; }

template <class Epi> __device__ __forceinline__ void run_epi(const Epi& E, const f32x4 (&acc)[2][2][4][2], const Unit& u, int wr, int wc, int fr, int fq) {
    const typename Epi::UPre up = E.upre(u.pn, wc, fq);
    typename Epi::Light lp[2][4];
#pragma unroll
    for (int ai = 0; ai < 2; ++ai)
#pragma unroll
        for (int m = 0; m < 4; ++m) lp[ai][m] = E.lpre(u.pm * BM + ai * HALF + wr * 64 + m * 16 + fr, u.pn, wc, fq);
#pragma unroll
    for (int b0 = 0; b0 < 8; b0 += Epi::HB) {
        typename Epi::Heavy hp[Epi::HB];
#pragma unroll
        for (int j = 0; j < Epi::HB; ++j) { const int ai = (b0 + j) >> 2, m = (b0 + j) & 3; hp[j] = E.hpre(u.pm * BM + ai * HALF + wr * 64 + m * 16 + fr, u.pn, wc, fq); }
#pragma unroll
        for (int j = 0; j < Epi::HB; ++j) { const int ai = (b0 + j) >> 2, m = (b0 + j) & 3;
            const f32x4 v[2][2] = {{acc[ai][0][m][0], acc[ai][0][m][1]}, {acc[ai][1][m][0], acc[ai][1][m][1]}};
            E.fin(u.pm * BM + ai * HALF + wr * 64 + m * 16 + fr, u.pn, wc, fq, v, lp[ai][m], hp[j], up);
        }
        asm volatile("" ::: "memory");
    }
}
template <class Epi, class Sched, bool ALIGN_EPI = false, bool SP2 = false>
__device__ __forceinline__ void gemm_phase(PG8_LAS unsigned char* lds, const Gemm g, const Sched& S, const Epi& E, const int tid) {
    const int wid = __builtin_amdgcn_readfirstlane(tid >> 6), lane = tid & 63, wr = wid >> 2, wc = wid & 3, fr = lane & 15, fq = lane >> 4;
    const int K = g.K, nt = K / BK;
    unsigned voffA[2], voffB[2];
#pragma unroll
    for (int i = 0; i < 2; ++i) { int R, C; stage_rc(tid * 16 + i * 8192, R, C); const int Rb = Epi::PERM ? ((R & ~31) + perm32(R & 31)) : R;
        voffA[i] = (unsigned)(R * K + C) * 2u; voffB[i] = (unsigned)(Rb * K + C) * 2u; }
    const size_t kstep = (size_t)(BK * 2);
    const size_t hstep = (size_t)HALF * K * 2;
    const size_t tstep = 2 * hstep;
    const unsigned ldsw = (unsigned)wid * 1024u;
    const int aoff = lds_byte(wr * 64 + fr, fq * 8), boff = lds_byte(wc * 32 + fr, fq * 8);
#define PG8_SA(b, h) (((b) * 2 + (h)) * HTB)
#define PG8_SB(b, h) ((4 + (b) * 2 + (h)) * HTB)
#define PG8_STAGE(bufoff, gbase, voff) do { _Pragma("unroll") for (int _i = 0; _i < 2; ++_i) \
        __builtin_amdgcn_global_load_lds((const unsigned*)((const char*)(gbase) + (voff)[_i]), (PG8_LAS unsigned*)(lds + (bufoff) + ldsw + _i * 8192), 16, 0, 0); } while (0)
#define PG8_LDA(dst, b, h) do { _Pragma("unroll") for (int m = 0; m < 4; ++m) _Pragma("unroll") for (int k = 0; k < 2; ++k) dst[m][k] = *(const PG8_LAS bf16x8*)(lds + PG8_SA(b, h) + aoff + m * 2048 + k * 1024); } while (0)
#define PG8_LDB(dst, b, h) do { _Pragma("unroll") for (int n = 0; n < 2; ++n) _Pragma("unroll") for (int k = 0; k < 2; ++k) dst[n][k] = *(const PG8_LAS bf16x8*)(lds + PG8_SB(b, h) + boff + n * 2048 + k * 1024); } while (0)
#define PG8_MMA(ai, bj, At, Bt) do { __builtin_amdgcn_s_setprio(1); _Pragma("unroll") for (int m = 0; m < 4; ++m) _Pragma("unroll") for (int n = 0; n < 2; ++n) _Pragma("unroll") for (int k = 0; k < 2; ++k) \
        acc[ai][bj][m][n] = __builtin_amdgcn_mfma_f32_16x16x32_bf16(Bt[n][k], At[m][k], acc[ai][bj][m][n], 0, 0, 0); __builtin_amdgcn_s_setprio(0); } while (0)
#define PG8_WAIT_V(n) asm volatile("s_waitcnt vmcnt(" #n ")" ::: "memory")
#define PG8_WAIT_L(n) asm volatile("s_waitcnt lgkmcnt(" #n ")" ::: "memory")
#define PG8_BAR __builtin_amdgcn_s_barrier()
#define PG8_SCHED __builtin_amdgcn_sched_barrier(0)
    Unit cur, nxt; int ui = 0;
    if (!S.next(0, cur)) return;
    f32x4 acc[2][2][4][2];
#pragma unroll
    for (int a = 0; a < 2; ++a)
#pragma unroll
        for (int b = 0; b < 2; ++b)
#pragma unroll
            for (int m = 0; m < 4; ++m)
#pragma unroll
                for (int n = 0; n < 2; ++n) acc[a][b][m][n] = (f32x4){0.f, 0.f, 0.f, 0.f};
    bf16x8 At[4][2], B0[2][2], B1[2][2];
    const char* cA = (const char*)g.A + (size_t)cur.pm * tstep; const char* cB = (const char*)g.Bt + (size_t)cur.pn * tstep;
    S.a_ready(cur);
    if constexpr (Epi::KHOOK) { E.hook_fill(lds, S, tid); asm volatile("s_waitcnt lgkmcnt(0)" ::: "memory"); PG8_BAR; asm volatile("" ::: "memory"); }
    if constexpr (SP2) {
        PG8_STAGE(PG8_SB(0, 0), cB, voffB); PG8_STAGE(PG8_SB(0, 1), cB + hstep, voffB); PG8_STAGE(PG8_SA(0, 0), cA, voffA); PG8_STAGE(PG8_SA(0, 1), cA + hstep, voffA);
        if (wr == 1) PG8_BAR;
        PG8_WAIT_V(2); PG8_BAR;
        PG8_STAGE(PG8_SB(1, 0), cB + kstep, voffB); PG8_STAGE(PG8_SA(1, 0), cA + kstep, voffA); PG8_STAGE(PG8_SB(1, 1), cB + hstep + kstep, voffB);
        PG8_WAIT_V(6); PG8_BAR;
    } else {
        PG8_STAGE(PG8_SB(0, 0), cB, voffB); PG8_STAGE(PG8_SA(0, 0), cA, voffA); PG8_STAGE(PG8_SB(0, 1), cB + hstep, voffB); PG8_STAGE(PG8_SA(0, 1), cA + hstep, voffA);
        if (wr == 1) PG8_BAR;
        PG8_WAIT_V(4); PG8_BAR;
        PG8_STAGE(PG8_SB(1, 0), cB + kstep, voffB); PG8_STAGE(PG8_SA(1, 0), cA + kstep, voffA); PG8_STAGE(PG8_SB(1, 1), cB + hstep + kstep, voffB);
        PG8_WAIT_V(6); PG8_BAR;
    }
    for (;;) {
        const bool has_next = S.next(ui + 1, nxt);
        const char* nA = has_next ? (const char*)g.A + (size_t)nxt.pm * tstep : cA; const char* nB = has_next ? (const char*)g.Bt + (size_t)nxt.pn * tstep : cB;
        for (int t = 0; t < nt; t += 2) {
            if constexpr (Epi::KHOOK) { if (t != 0 && (t & 7) == 0) E.hook_scale(acc, lds, ui, (t >> 3) - 1, wr); }
            const bool last = (t == nt - 2);
            const char* a1 = cA + (size_t)(t + 1) * kstep;
            const char* a2 = last ? nA : cA + (size_t)(t + 2) * kstep; const char* b2 = last ? nB : cB + (size_t)(t + 2) * kstep;
            const char* a3 = a2 + kstep; const char* b3 = b2 + kstep;
            if (last && has_next) S.a_ready(nxt);
            if constexpr (SP2) {
            PG8_LDB(B0, 0, 0); PG8_LDB(B1, 0, 1); PG8_SCHED; PG8_LDA(At, 0, 0); PG8_STAGE(PG8_SA(1, 1), a1 + hstep, voffA);
            PG8_WAIT_V(8); PG8_WAIT_L(0); PG8_BAR; PG8_MMA(0, 0, At, B0); PG8_MMA(0, 1, At, B1); PG8_BAR; PG8_SCHED;
            PG8_LDA(At, 0, 1); PG8_STAGE(PG8_SB(0, 0), b2, voffB); PG8_STAGE(PG8_SB(0, 1), b2 + hstep, voffB); PG8_STAGE(PG8_SA(0, 0), a2, voffA);
            PG8_WAIT_V(8); PG8_WAIT_L(0); PG8_BAR; PG8_MMA(1, 0, At, B0); PG8_MMA(1, 1, At, B1); PG8_BAR; PG8_SCHED;
            PG8_LDB(B0, 1, 0); PG8_LDB(B1, 1, 1); PG8_SCHED; PG8_LDA(At, 1, 0); PG8_STAGE(PG8_SA(0, 1), a2 + hstep, voffA);
            PG8_WAIT_V(8); PG8_WAIT_L(0); PG8_BAR; PG8_MMA(0, 0, At, B0); PG8_MMA(0, 1, At, B1); PG8_BAR; PG8_SCHED;
            PG8_LDA(At, 1, 1); PG8_STAGE(PG8_SB(1, 0), b3, voffB); PG8_STAGE(PG8_SB(1, 1), b3 + hstep, voffB); PG8_STAGE(PG8_SA(1, 0), a3, voffA);
            PG8_WAIT_V(8); PG8_WAIT_L(0); PG8_BAR; PG8_MMA(1, 0, At, B0); PG8_MMA(1, 1, At, B1); PG8_BAR; PG8_SCHED;
            } else {
            PG8_LDB(B0, 0, 0); PG8_SCHED; PG8_LDA(At, 0, 0); PG8_STAGE(PG8_SA(1, 1), a1 + hstep, voffA);
            PG8_WAIT_L(8); PG8_BAR; PG8_WAIT_L(0); PG8_MMA(0, 0, At, B0); PG8_BAR; PG8_SCHED;
            PG8_LDB(B1, 0, 1); PG8_STAGE(PG8_SB(0, 0), b2, voffB);
            PG8_BAR; PG8_WAIT_L(0); PG8_MMA(0, 1, At, B1); PG8_BAR;
            PG8_LDA(At, 0, 1); PG8_STAGE(PG8_SA(0, 0), a2, voffA);
            PG8_BAR; PG8_WAIT_L(0); PG8_MMA(1, 0, At, B0); PG8_BAR; PG8_SCHED;
            PG8_STAGE(PG8_SB(0, 1), b2 + hstep, voffB);
            PG8_WAIT_V(6); PG8_BAR; PG8_MMA(1, 1, At, B1); PG8_BAR;
            PG8_LDB(B0, 1, 0); PG8_SCHED; PG8_LDA(At, 1, 0); PG8_STAGE(PG8_SA(0, 1), a2 + hstep, voffA);
            PG8_WAIT_L(8); PG8_BAR; PG8_WAIT_L(0); PG8_MMA(0, 0, At, B0); PG8_BAR; PG8_SCHED;
            PG8_LDB(B1, 1, 1); PG8_STAGE(PG8_SB(1, 0), b3, voffB);
            PG8_BAR; PG8_WAIT_L(0); PG8_MMA(0, 1, At, B1); PG8_BAR;
            PG8_LDA(At, 1, 1); PG8_STAGE(PG8_SA(1, 0), a3, voffA);
            PG8_BAR; PG8_WAIT_L(0); PG8_MMA(1, 0, At, B0); PG8_BAR; PG8_SCHED;
            PG8_STAGE(PG8_SB(1, 1), b3 + hstep, voffB);
            PG8_WAIT_V(6); PG8_BAR; PG8_MMA(1, 1, At, B1); PG8_BAR;
            }
        }
        if constexpr (Epi::KHOOK) E.hook_scale(acc, lds, ui, (nt >> 3) - 1, wr);
        if constexpr (ALIGN_EPI) { if (wr == 0) PG8_BAR; }
        if constexpr (!Epi::AFTER_DRAIN) { int l2_; asm volatile("v_mbcnt_lo_u32_b32 %0, -1, 0\n\tv_mbcnt_hi_u32_b32 %0, -1, %0" : "=v"(l2_));
            run_epi(E, acc, cur, wr, wc, l2_ & 15, l2_ >> 4); S.done(cur); }
        if (!has_next) break;
#pragma unroll
        for (int a = 0; a < 2; ++a)
#pragma unroll
            for (int b = 0; b < 2; ++b)
#pragma unroll
                for (int m = 0; m < 4; ++m)
#pragma unroll
                    for (int n = 0; n < 2; ++n) acc[a][b][m][n] = (f32x4){0.f, 0.f, 0.f, 0.f};
        cur = nxt; cA = nA; cB = nB; ++ui;
        if constexpr (ALIGN_EPI) { if (wr == 1) PG8_BAR; }
    }
    PG8_WAIT_V(0);
    if constexpr (!ALIGN_EPI) { if (wr == 0) PG8_BAR; }
    PG8_BAR;
    if constexpr (Epi::AFTER_DRAIN) { E.fused(acc, cur, wr, wc, fr, fq, lds, wid, lane); S.done(cur); }
#undef PG8_SA
#undef PG8_SB
#undef PG8_STAGE
#undef PG8_LDA
#undef PG8_LDB
#undef PG8_MMA
#undef PG8_WAIT_V
#undef PG8_WAIT_L
#undef PG8_BAR
#undef PG8_SCHED
}
}

#define LAS __attribute__((address_space(3)))
#define XB_TMO      128
#define XB_XCNT(j)  (256  + 64 * (j))
#define XB_XSUB(j)  (1280 + 64 * (j))
#define XB_XGEN(j)  (2304 + 64 * (j))
#define XB_TOP      3328
#define XB_TOPGEN   3392
#define XCD_BAR_WORDS 3456
#define XB_SPIN_CAP (1u << 18)
__device__ __forceinline__ unsigned xb_ld(unsigned* p)              { return __hip_atomic_load(p, __ATOMIC_RELAXED, __HIP_MEMORY_SCOPE_AGENT); }
__device__ __forceinline__ unsigned xb_add(unsigned* p, unsigned v) { return __hip_atomic_fetch_add(p, v, __ATOMIC_RELAXED, __HIP_MEMORY_SCOPE_AGENT); }
__device__ __forceinline__ unsigned xb_xcc_id() { return (unsigned)__builtin_amdgcn_s_getreg((3 << 11) | 20) & 0xFu; }
#define XB_SPIN(cond, bar) do { unsigned _sp = 0; while (cond) { __builtin_amdgcn_s_sleep(1); \
    if ((++_sp & 255u) == 0u) { if (xb_ld(&(bar)[XB_TMO])) break; if (_sp > XB_SPIN_CAP) { atomicAdd(&(bar)[XB_TMO], 1u); break; } } } } while (0)
struct XcdBarrier { unsigned* bar; unsigned x; volatile LAS unsigned* st; };
__device__ __forceinline__ XcdBarrier xcd_barrier_post(unsigned* bar, volatile LAS unsigned* st) {
    XcdBarrier b; b.bar = bar; b.x = xb_xcc_id(); b.st = st;
    if (threadIdx.x == 0) (void)xb_add(&bar[XB_XCNT(b.x)], 1u);
    return b;
}
__device__ __forceinline__ void xcd_barrier_complete(unsigned* bar, unsigned x, unsigned& nloc, unsigned& nx) {
    const unsigned G = gridDim.x * gridDim.y * gridDim.z;
    unsigned sum, cnt, mine, sp = 0u;
    for (;;) {
        sum = 0u; cnt = 0u; mine = 0u;
#pragma unroll
        for (unsigned j = 0; j < 16; ++j) { const unsigned c = xb_ld(&bar[XB_XCNT(j)]); sum += c; cnt += (c > 0u) ? 1u : 0u; mine = (j == x) ? c : mine; }
        if (sum == G) break;
        __builtin_amdgcn_s_sleep(1);
        if ((++sp & 255u) == 0u) { if (xb_ld(&bar[XB_TMO])) break; if (sp > XB_SPIN_CAP) { atomicAdd(&bar[XB_TMO], 1u); break; } }
    }
    nloc = mine > 0u ? mine : 1u; nx = cnt > 0u ? cnt : 1u;
}
__device__ __forceinline__ void xcd_barrier(const XcdBarrier& b) {
    asm volatile("s_waitcnt vmcnt(0)" ::: "memory");
    __syncthreads();
    if (threadIdx.x == 0) {
        unsigned* bar = b.bar;
        __builtin_amdgcn_s_waitcnt(0);
        unsigned nloc = b.st[0], nx = b.st[1];
        if (nloc == 0u) { xcd_barrier_complete(bar, b.x, nloc, nx); b.st[0] = nloc; b.st[1] = nx; }
        const unsigned old = xb_add(&bar[XB_XSUB(b.x)], 1u);
        const unsigned gen = old / nloc;
        if (old + 1u == (gen + 1u) * nloc) {
            __builtin_amdgcn_fence(__ATOMIC_RELEASE, "agent");
            asm volatile("s_waitcnt vmcnt(0)" ::: "memory");
            const unsigned og = xb_add(&bar[XB_TOP], 1u);
            const unsigned tg = og / nx;
            if (og + 1u == (tg + 1u) * nx) xb_add(&bar[XB_TOPGEN], 1u);
            else XB_SPIN(xb_ld(&bar[XB_TOPGEN]) == tg, bar);
            __builtin_amdgcn_fence(__ATOMIC_ACQUIRE, "agent");
            xb_add(&bar[XB_XGEN(b.x)], 1u);
            asm volatile("s_waitcnt vmcnt(0)" ::: "memory");
        } else {
            XB_SPIN(xb_ld(&bar[XB_XGEN(b.x)]) == gen, bar);
            __builtin_amdgcn_fence(__ATOMIC_ACQUIRE, "agent");
            asm volatile("s_waitcnt vmcnt(0)" ::: "memory");
        }
    }
    __syncthreads();
}


namespace ret {
typedef short v4i16_t __attribute__((ext_vector_type(4)));
constexpr int QP = 528, KSP = 544, VP = 144, OSP = 68;
constexpr int L_QS = 0, L_KS = 64 * QP, L_VS = 64 * QP + 64 * KSP, L_PS = L_VS + 64 * VP, L_OS0 = L_PS + 64 * VP, L_OS1 = L_OS0 + 64 * OSP * 4, L_END = L_OS1 + 64 * OSP * 4;
static_assert(L_END <= 131072 && (L_KS % 16) == 0 && (L_VS % 16) == 0 && (L_PS % 16) == 0 && (L_OS0 % 16) == 0 && (L_OS1 % 16) == 0, "retention LDS map");
__device__ __forceinline__ v4i16_t trrd(LAS const unsigned char* p) { return __builtin_amdgcn_ds_read_tr16_b64_v4i16((LAS v4i16_t*)p); }
__device__ __forceinline__ bf16x8 cat8(v4i16_t lo, v4i16_t hi) { return (bf16x8){lo[0], lo[1], lo[2], lo[3], hi[0], hi[1], hi[2], hi[3]}; }

__device__ __forceinline__ void scores_phase(LAS unsigned char* l3, const bf16_t* Q, const bf16_t* K, bf16_t* PP, int tid, int G, int bx) {
    const int lane = tid & 63, wid = __builtin_amdgcn_readfirstlane(tid >> 6), r = lane & 15, q4 = lane >> 4, tt = wid >> 1, st0 = 2 * (wid & 1);
    constexpr int NCHH = BATCH * RH * NCH;
    u32x4 rq[4], rk[4];
#define SC_LOAD(ch) do { const int ch_ = (ch) < NCHH ? (ch) : NCHH - 1; const int cidx_ = ch_ & 63, h_ = (ch_ >> 6) & 3, b_ = ch_ >> 8; \
        const size_t row0_ = (size_t)b_ * SEQ + (size_t)cidx_ * CH; \
        _Pragma("unroll") for (int i = 0; i < 4; ++i) { const int p_ = tid + 512 * i, rw_ = p_ >> 5, c8_ = (p_ & 31) * 8; \
            rq[i] = *(const u32x4*)(Q + (row0_ + rw_) * 1024 + h_ * 256 + c8_); rk[i] = *(const u32x4*)(K + (row0_ + rw_) * 1024 + h_ * 256 + c8_); } } while (0)
    SC_LOAD(bx);
    for (int ch = bx; ch < NCHH; ch += G) {
        __syncthreads();
#pragma unroll
        for (int i = 0; i < 4; ++i) { const int p_ = tid + 512 * i, rw_ = p_ >> 5, c8_ = (p_ & 31) * 8;
            *(LAS u32x4*)(l3 + L_QS + rw_ * QP + c8_ * 2) = rq[i]; *(LAS u32x4*)(l3 + L_KS + rw_ * QP + c8_ * 2) = rk[i]; }
        SC_LOAD(ch + G);
        __syncthreads();
        const int h_ = (ch >> 6) & 3; const float l2g = ret_l2g(h_);
        f32x4 d0 = {0.f, 0.f, 0.f, 0.f}, d1 = {0.f, 0.f, 0.f, 0.f};
#pragma unroll
        for (int ks = 0; ks < 8; ++ks) {
            const bf16x8 a = *(LAS const bf16x8*)(l3 + L_QS + (16 * tt + r) * QP + (32 * ks + 8 * q4) * 2);
            LAS const unsigned char* kp0 = l3 + L_KS + (16 * st0 + r) * QP + (32 * ks + 4 * q4) * 2;
            const u32x2 l0 = *(LAS const u32x2*)kp0, h0 = *(LAS const u32x2*)(kp0 + 32), l1 = *(LAS const u32x2*)(kp0 + 16 * QP), h1 = *(LAS const u32x2*)(kp0 + 16 * QP + 32);
            const u32x4 w0 = {l0.x, l0.y, h0.x, h0.y}, w1 = {l1.x, l1.y, h1.x, h1.y};
            d0 = __builtin_amdgcn_mfma_f32_16x16x32_bf16(a, __builtin_bit_cast(bf16x8, w0), d0, 0, 0, 0);
            d1 = __builtin_amdgcn_mfma_f32_16x16x32_bf16(a, __builtin_bit_cast(bf16x8, w1), d1, 0, 0, 0);
        }
        bf16_t* pp = PP + (size_t)ch * 4096;
#pragma unroll
        for (int g = 0; g < 4; ++g) { const int t = 16 * tt + 4 * q4 + g, s0 = 16 * st0 + r, s1 = s0 + 16;
            pp[t * 64 + s0] = (bf16_t)f2bf(d0[g] * ret_pfac(l2g, t, s0)); pp[t * 64 + s1] = (bf16_t)f2bf(d1[g] * ret_pfac(l2g, t, s1)); }
    }
#undef SC_LOAD
    __syncthreads();
}

__device__ __forceinline__ void scan_phase(LAS unsigned char* l3, const bf16_t* Q, const bf16_t* K, const bf16_t* Vd, bf16_t* GY, const bf16_t* PP, float* ssh, int tid, int bx) {
    const int lane = tid & 63, wid = __builtin_amdgcn_readfirstlane(tid >> 6), dkh = wid >> 2, dvq = wid & 3, r = lane & 15, q4 = lane >> 4;
    const int pair = (bx & 7) * 4 + (bx >> 6), slice = (bx >> 3) & 7, b = pair >> 2, h = pair & 3;
    const float l2g = ret_l2g(h), sdec = exp2f(l2g * 64.f);
    const int ft = tid >> 3, fd8 = (tid & 7) * 8;
    const float qdec = exp2f(l2g * (float)(ft + 1));
    f32x4 S[8];
#pragma unroll
    for (int i = 0; i < 8; ++i) S[i] = (f32x4){0.f, 0.f, 0.f, 0.f};
    const bf16_t* qg = Q + (size_t)b * SEQ * 1024 + h * 256; const bf16_t* kg = K + (size_t)b * SEQ * 1024 + h * 256;
    const bf16_t* vg = Vd + (size_t)b * SEQ * 2048 + h * 512 + slice * 64; bf16_t* gg = GY + (size_t)b * SEQ * 2048 + h * 512 + slice * 64;
    const bf16_t* pg = PP + (size_t)((b * 4 + h) * 64) * 4096;
    float* ssp = ssh + (size_t)h * 8 + slice;
    u32x4 rqX[4], rkX[4], rvX, rpX, rgX, rqY[4], rkY[4], rvY, rpY, rgY;
#define RET_LOADK(rk, c) do { const size_t r0_ = (size_t)(c) * CH; \
        _Pragma("unroll") for (int i = 0; i < 4; ++i) { const int p_ = tid + 512 * i, rw_ = p_ >> 5, c8_ = (p_ & 31) * 8; rk[i] = *(const u32x4*)(kg + (r0_ + rw_) * 1024 + c8_); } } while (0)
#define RET_LOADQ(rq, rv, rp, c) do { const size_t r0_ = (size_t)(c) * CH; \
        _Pragma("unroll") for (int i = 0; i < 4; ++i) { const int p_ = tid + 512 * i, rw_ = p_ >> 5, c8_ = (p_ & 31) * 8; rq[i] = *(const u32x4*)(qg + (r0_ + rw_) * 1024 + c8_); } \
        rv = *(const u32x4*)(vg + (r0_ + ft) * 2048 + fd8); rp = *(const u32x4*)(pg + (size_t)(c) * 4096 + ft * 64 + fd8); } while (0)
#define RET_LOADG(rg, c) do { rg = *(const u32x4*)(gg + ((size_t)(c) * CH + ft) * 2048 + fd8); } while (0)
#define RET_STK(rk) do { _Pragma("unroll") for (int i = 0; i < 4; ++i) { const int p_ = tid + 512 * i, rw_ = p_ >> 5, c8_ = (p_ & 31) * 8; *(LAS u32x4*)(l3 + L_KS + rw_ * KSP + ((c8_ * 2) ^ (((rw_ >> 3) & 1) << 7))) = rk[i]; } } while (0)
#define RET_STQ(rq, rv, rp) do { _Pragma("unroll") for (int i = 0; i < 4; ++i) { const int p_ = tid + 512 * i, rw_ = p_ >> 5, c8_ = (p_ & 31) * 8; *(LAS u32x4*)(l3 + L_QS + rw_ * QP + c8_ * 2) = rq[i]; } \
        *(LAS u32x4*)(l3 + L_VS + ft * VP + fd8 * 2) = rv; *(LAS u32x4*)(l3 + L_PS + ft * VP + fd8 * 2) = rp; } while (0)
#define RET_CHUNK(c, rkC, rgC, rqN, rvN, rpN) do { \
          \
        RET_STK(rkC); RET_LOADK(rkC, ((c) + 2 < NCH ? (c) + 2 : NCH - 1)); \
        bf16x8 vb[2]; \
        _Pragma("unroll") for (int ks = 0; ks < 2; ++ks) { LAS const unsigned char* vp = l3 + L_VS + (32 * ks + 8 * q4 + (r >> 2)) * VP + (16 * dvq + 4 * (r & 3)) * 2; \
            vb[ks] = cat8(trrd(vp), trrd(vp + 4 * VP)); } \
        f32x4 O[4]; \
        _Pragma("unroll") for (int t4 = 0; t4 < 4; ++t4) { const bf16x8 a = *(LAS const bf16x8*)(l3 + L_PS + (16 * t4 + r) * VP + (32 * dkh + 8 * q4) * 2); \
            O[t4] = __builtin_amdgcn_mfma_f32_16x16x32_bf16(a, dkh ? vb[1] : vb[0], (f32x4){0.f, 0.f, 0.f, 0.f}, 0, 0, 0); } \
        _Pragma("unroll") for (int m = 0; m < 4; ++m) { \
            u32x4 sw; sw.x = pk2(S[2 * m][0], S[2 * m][1]); sw.y = pk2(S[2 * m][2], S[2 * m][3]); sw.z = pk2(S[2 * m + 1][0], S[2 * m + 1][1]); sw.w = pk2(S[2 * m + 1][2], S[2 * m + 1][3]); \
            const bf16x8 sb = __builtin_bit_cast(bf16x8, sw); \
            _Pragma("unroll") for (int t4 = 0; t4 < 4; ++t4) { const bf16x8 aq = *(LAS const bf16x8*)(l3 + L_QS + (16 * t4 + r) * QP + (128 * dkh + 32 * m + 8 * q4) * 2); \
                O[t4] = __builtin_amdgcn_mfma_f32_16x16x32_bf16(aq, sb, O[t4], 0, 0, 0); } \
        } \
        { LAS float* os = (LAS float*)(l3 + (dkh ? L_OS1 : L_OS0)); \
          _Pragma("unroll") for (int t4 = 0; t4 < 4; ++t4) _Pragma("unroll") for (int g = 0; g < 4; ++g) os[(16 * t4 + 4 * q4 + g) * OSP + 16 * dvq + r] = O[t4][g]; } \
        __syncthreads(); \
          \
        _Pragma("unroll") for (int i = 0; i < 8; ++i) { \
            S[i] = S[i] * sdec; \
            _Pragma("unroll") for (int ks = 0; ks < 2; ++ks) { LAS const unsigned char* kp = l3 + L_KS + (32 * ks + 8 * q4 + (r >> 2)) * KSP + (((128 * dkh + 16 * i + 4 * (r & 3)) * 2) ^ ((q4 & 1) << 7)); \
                S[i] = __builtin_amdgcn_mfma_f32_16x16x32_bf16(cat8(trrd(kp), trrd(kp + 4 * KSP)), vb[ks], S[i], 0, 0, 0); } \
        } \
        { const LAS float* o0 = (const LAS float*)(l3 + L_OS0) + ft * OSP + fd8; const LAS float* o1 = (const LAS float*)(l3 + L_OS1) + ft * OSP + fd8; \
          const f32x4 a0 = *(const LAS f32x4*)o0, a1 = *(const LAS f32x4*)(o0 + 4), b0 = *(const LAS f32x4*)o1, b1 = *(const LAS f32x4*)(o1 + 4); \
          const f32x4 x0 = (a0 + b0) * qdec, x1 = (a1 + b1) * qdec; \
          float part = (x0[0] * x0[0] + x0[1] * x0[1]) + (x0[2] * x0[2] + x0[3] * x0[3]) + (x1[0] * x1[0] + x1[1] * x1[1]) + (x1[2] * x1[2] + x1[3] * x1[3]); \
          part = addx<1>(part); part = addx<2>(part); part = addx<4>(part); \
          const size_t grow = (size_t)b * SEQ + (size_t)(c) * CH + ft; \
          if ((tid & 7) == 0) ssp[grow * 32] = part;                 \
          u32x4 w; w.x = pk2(bflo(rgC.x) * x0[0], bfhi(rgC.x) * x0[1]); w.y = pk2(bflo(rgC.y) * x0[2], bfhi(rgC.y) * x0[3]); \
          w.z = pk2(bflo(rgC.z) * x1[0], bfhi(rgC.z) * x1[1]); w.w = pk2(bflo(rgC.w) * x1[2], bfhi(rgC.w) * x1[3]); \
          *(u32x4*)(gg + ((size_t)(c) * CH + ft) * 2048 + fd8) = w; \
          RET_LOADG(rgC, ((c) + 2 < NCH ? (c) + 2 : (c))); } \
        RET_STQ(rqN, rvN, rpN); RET_LOADQ(rqN, rvN, rpN, ((c) + 3 < NCH ? (c) + 3 : NCH - 1)); \
        __syncthreads(); } while (0)
    RET_LOADQ(rqX, rvX, rpX, 0); RET_LOADK(rkX, 0); RET_LOADG(rgX, 0);
    RET_LOADQ(rqY, rvY, rpY, 1); RET_LOADK(rkY, 1); RET_LOADG(rgY, 1);
    RET_STQ(rqX, rvX, rpX); RET_LOADQ(rqX, rvX, rpX, 2);
    __syncthreads();
    for (int c = 0; c < NCH; c += 2) {
        RET_CHUNK(c, rkX, rgX, rqY, rvY, rpY);
        RET_CHUNK(c + 1, rkY, rgY, rqX, rvX, rpX);
    }
#undef RET_CHUNK
#undef RET_LOADK
#undef RET_LOADQ
#undef RET_LOADG
#undef RET_STK
#undef RET_STQ
}
__device__ __forceinline__ void norm_phase(bf16_t* GY, const float* ssh, int tid, int G, int bx) {
    for (size_t i = ((size_t)bx * 512 + tid) * 8; i < (size_t)MTOK * 2048; i += (size_t)G * 512 * 8) {
        const size_t m = i >> 11; const int h = (int)((i & 2047) >> 9);
        const f32x4 q0 = *(const f32x4*)(ssh + (m * 4 + h) * 8), q1 = *(const f32x4*)(ssh + (m * 4 + h) * 8 + 4);
        const float rr = rstd_of(((q0[0] + q0[1]) + (q0[2] + q0[3])) + ((q1[0] + q1[1]) + (q1[2] + q1[3])), 1.f / 512.f);
        const u32x4 y = *(const u32x4*)(GY + i); u32x4 w;
        w.x = pk2(bflo(y.x) * rr, bfhi(y.x) * rr); w.y = pk2(bflo(y.y) * rr, bfhi(y.y) * rr); w.z = pk2(bflo(y.z) * rr, bfhi(y.z) * rr); w.w = pk2(bflo(y.w) * rr, bfhi(y.w) * rr);
        *(u32x4*)(GY + i) = w;
    }
}
}


namespace att {
typedef float f32x16 __attribute__((ext_vector_type(16)));
constexpr int KP = 144;
constexpr int VPA = 192;
constexpr int L_K = 0, L_V = 4 * 64 * KP, L_TB = 4 * 64 * KP + 4 * 64 * VPA, TBN = 384;
__device__ __forceinline__ void attention_phase(LAS unsigned char* l3, const bf16_t* Q2, const bf16_t* K2, const bf16_t* V2, const float* rel_bias, const float* qgain, const float* kgain, bf16_t* O2, int tid, int bx) {
    const int lane = tid & 63, wid = __builtin_amdgcn_readfirstlane(tid >> 6), r32 = lane & 31, hi = lane >> 5;
    const int b = bx & 7, h = bx >> 4, c4base = ((bx >> 3) & 1) * 8;
    LAS float* TB = (LAS float*)(l3 + L_TB);
    float gq = fabsf(qgain[lane]), gk = fabsf(kgain[lane]), bm = -1e30f;
    for (int j = lane; j < RELT; j += 64) bm = fmaxf(bm, rel_bias[h * RELT + j]);
#define ATT_WMAX(x) do { x = maxx<1>(x); x = maxx<2>(x); x = maxx<4>(x); x = maxx<8>(x); x = maxx<16>(x); x = maxx<32>(x); } while (0)
    ATT_WMAX(gq); ATT_WMAX(gk); ATT_WMAX(bm);
#undef ATT_WMAX
    const float shift = LOG2E * (8.08f * gq * gk + bm);
    __syncthreads();
    for (int u = tid; u < TBN; u += 512) { const int dist = u - 63; TB[u] = rel_bias[h * RELT + (dist > RELCLIP ? RELCLIP : dist) + RELCLIP] * LOG2E - shift; }
    const float cfar = rel_bias[h * RELT + 2 * RELCLIP] * LOG2E - shift;
    __syncthreads();
    const int sr = tid >> 3, sc8 = (tid & 7) * 8;
    const int qi_l = wid >> 1;
    const int qr = 32 * (wid & 1) + r32;
    const int i16 = lane & 15, g4 = lane >> 4;
    for (int ui = 0; ui < 8; ++ui) {
        const int c4 = c4base + ui, qi = 4 * c4 + qi_l;
        const int kc_lo = (4 * c4 - PAST) < 0 ? 0 : 4 * c4 - PAST, npairs = (4 * c4 + 4 - kc_lo) >> 1;
        const size_t qrow = (size_t)b * SEQ + (size_t)qi * CH + qr;
        bf16x8 qf[4];
#pragma unroll
        for (int ks = 0; ks < 4; ++ks) qf[ks] = *(const bf16x8*)(Q2 + qrow * 1024 + h * 64 + 16 * ks + 8 * hi);
        f32x16 o0, o1; float lsum = 0.f;
#pragma unroll
        for (int g = 0; g < 16; ++g) { o0[g] = 0.f; o1[g] = 0.f; }
        const bf16_t* kbase = K2 + (size_t)b * SEQ * 1024 + h * 64 + (size_t)sr * 1024 + sc8;
        const bf16_t* vbase = V2 + (size_t)b * SEQ * 1024 + h * 64 + (size_t)sr * 1024 + sc8;
        u32x4 rk[2], rv[2];
#pragma unroll
        for (int t = 0; t < 2; ++t) { rk[t] = *(const u32x4*)(kbase + (size_t)(kc_lo + t) * CH * 1024); rv[t] = *(const u32x4*)(vbase + (size_t)(kc_lo + t) * CH * 1024); }
        for (int kp = 0; kp < npairs; ++kp) {
            const int pbo = (kp & 1) * 2 * 64 * KP, pbv = (kp & 1) * 2 * 64 * VPA;
#pragma unroll
            for (int t = 0; t < 2; ++t) { *(LAS u32x4*)(l3 + L_K + pbo + t * 64 * KP + sr * KP + sc8 * 2) = rk[t]; *(LAS u32x4*)(l3 + L_V + pbv + t * 64 * VPA + sr * VPA + sc8 * 2) = rv[t]; }
            { const int kn = kc_lo + 2 * ((kp + 1 < npairs) ? kp + 1 : kp);
#pragma unroll
              for (int t = 0; t < 2; ++t) { rk[t] = *(const u32x4*)(kbase + (size_t)(kn + t) * CH * 1024); rv[t] = *(const u32x4*)(vbase + (size_t)(kn + t) * CH * 1024); } }
            __syncthreads();
            const int dcA = qi - (kc_lo + 2 * kp), dcB = dcA - 1;
            const bool actA = dcA >= 0 && dcA <= PAST, actB = dcB >= 0 && dcB <= PAST;
            if (actA || actB) {
                f32x16 p[2][2];
#pragma unroll
                for (int t = 0; t < 2; ++t) {
                    const int dc = t ? dcB : dcA; const bool act = t ? actB : actA;
                    if (act && dc <= 4) {
                        const LAS float* tb = TB + (64 * dc + qr + 63 - 4 * hi - 59);
#pragma unroll
                        for (int g = 0; g < 16; ++g) { p[t][0][g] = tb[59 - ((g & 3) + 8 * (g >> 2))]; p[t][1][g] = tb[59 - (32 + (g & 3) + 8 * (g >> 2))]; }
                    } else {
                        const float cv = act ? cfar : -INFINITY;
#pragma unroll
                        for (int g = 0; g < 16; ++g) { p[t][0][g] = cv; p[t][1][g] = cv; }
                    }
                }
#pragma unroll
                for (int t = 0; t < 2; ++t) {
                    LAS const unsigned char* kb = l3 + L_K + pbo + t * 64 * KP;
#pragma unroll
                    for (int ks = 0; ks < 4; ++ks) {
                        const bf16x8 k0 = *(LAS const bf16x8*)(kb + r32 * KP + (16 * ks + 8 * hi) * 2), k1 = *(LAS const bf16x8*)(kb + (32 + r32) * KP + (16 * ks + 8 * hi) * 2);
                        p[t][0] = __builtin_amdgcn_mfma_f32_32x32x16_bf16(k0, qf[ks], p[t][0], 0, 0, 0);
                        p[t][1] = __builtin_amdgcn_mfma_f32_32x32x16_bf16(k1, qf[ks], p[t][1], 0, 0, 0);
                    }
                }
#pragma unroll
                for (int t = 0; t < 2; ++t) {
                    float ls = 0.f;
#pragma unroll
                    for (int g = 0; g < 16; ++g) { p[t][0][g] = __builtin_amdgcn_exp2f(p[t][0][g]); p[t][1][g] = __builtin_amdgcn_exp2f(p[t][1][g]); ls += p[t][0][g] + p[t][1][g]; }
                    lsum += ls;
                    bf16x8 pf[2][2];
#pragma unroll
                    for (int n = 0; n < 2; ++n)
#pragma unroll
                        for (int s2 = 0; s2 < 2; ++s2) { u32x4 w; w.x = pk2(p[t][n][8 * s2 + 0], p[t][n][8 * s2 + 1]); w.y = pk2(p[t][n][8 * s2 + 2], p[t][n][8 * s2 + 3]);
                            w.z = pk2(p[t][n][8 * s2 + 4], p[t][n][8 * s2 + 5]); w.w = pk2(p[t][n][8 * s2 + 6], p[t][n][8 * s2 + 7]); pf[n][s2] = __builtin_bit_cast(bf16x8, w); }
                    LAS const unsigned char* vp = l3 + L_V + pbv + t * 64 * VPA + (4 * (g4 >> 1) + (i16 >> 2)) * VPA + (16 * (g4 & 1) + 4 * (i16 & 3)) * 2;
#pragma unroll
                    for (int n = 0; n < 2; ++n)
#pragma unroll
                        for (int s2 = 0; s2 < 2; ++s2) {
                            LAS const unsigned char* vq = vp + (32 * n + 16 * s2) * VPA;
                            const bf16x8 a0 = ret::cat8(ret::trrd(vq), ret::trrd(vq + 8 * VPA)), a1 = ret::cat8(ret::trrd(vq + 64), ret::trrd(vq + 8 * VPA + 64));
                            o0 = __builtin_amdgcn_mfma_f32_32x32x16_bf16(a0, pf[n][s2], o0, 0, 0, 0);
                            o1 = __builtin_amdgcn_mfma_f32_32x32x16_bf16(a1, pf[n][s2], o1, 0, 0, 0);
                        }
                }
            }
        }
        lsum = addx<32>(lsum);
        const float il = 1.0f / lsum;
        bf16_t* op = O2 + qrow * 1024 + h * 64 + 4 * hi;
#pragma unroll
        for (int k4 = 0; k4 < 4; ++k4) {
            u32x2 w; w.x = pk2(o0[4 * k4] * il, o0[4 * k4 + 1] * il); w.y = pk2(o0[4 * k4 + 2] * il, o0[4 * k4 + 3] * il); *(u32x2*)(op + 8 * k4) = w;
            u32x2 z; z.x = pk2(o1[4 * k4] * il, o1[4 * k4 + 1] * il); z.y = pk2(o1[4 * k4 + 2] * il, o1[4 * k4 + 3] * il); *(u32x2*)(op + 32 + 8 * k4) = z;
        }
        __syncthreads();
    }
}
}

__device__ __forceinline__ int phase_tid(int wave) { int ln_; asm volatile("v_mbcnt_lo_u32_b32 %0, -1, 0\n\tv_mbcnt_hi_u32_b32 %0, -1, %0" : "=v"(ln_)); return wave * 64 + ln_; }
constexpr int NPH = 13;
constexpr int CW_BAR = 4096;
constexpr int RING_BYTES = 131072, LDSCTL_OFF = RING_BYTES, MISC_OFF = LDSCTL_OFF + 320, LDS_BYTES = 147456;
struct MArgs { Ptrs P; };
typedef const __attribute__((address_space(4))) Ptrs* KPtrs;
#if defined(PROBE_MASK)
#define PROBE_STAMP(k) do { if (threadIdx.x == 0) ((volatile LAS unsigned*)(l3 + MISC_OFF + 64))[(k) + 1] = (unsigned)__builtin_amdgcn_s_memrealtime(); } while (0)
#else
#define PROBE_STAMP(k) do { } while (0)
#endif
#define PHASE_BEGIN { KPtrs kq = kp0; asm volatile("" : "+s"(kq)); unsigned char* const ws = kq->ws; float* const outp = kq->out; (void)outp; \
        int bxl = (int)blockIdx.x; asm volatile("" : "+s"(bxl)); const int tl = phase_tid(wave); (void)tl; (void)bxl;
#define PHASE_END(k) } xcd_barrier(bar); PROBE_STAMP(k);
#define BFW(off) ((bf16_t*)(ws + (off)))
#define F32W(off) ((float*)(ws + (off)))
template <class Epi> __device__ __forceinline__ void gemm_run(LAS unsigned char* l3, const bf16_t* A, const bf16_t* Bt, int N, int K, const Epi& E, int tl, int bxl) {
    pg8::Gemm g{A, Bt, MTOK, N, K}; pg8::StaticOrder S; S.init(MTOK, N, 256, bxl);
    pg8::gemm_phase<Epi, pg8::StaticOrder, true, true>(l3, g, S, E, tl);
}
__global__ void __launch_bounds__(512, 2) mega(MArgs a_unused) {
    extern __shared__ __attribute__((aligned(16))) unsigned char lds[];
    LAS unsigned char* l3 = (LAS unsigned char*)lds;
    volatile LAS unsigned* MISC = (volatile LAS unsigned*)(l3 + MISC_OFF);
    const int wave = __builtin_amdgcn_readfirstlane((int)threadIdx.x >> 6);
    const KPtrs kp0 = (KPtrs)__builtin_amdgcn_kernarg_segment_ptr();
    for (int u = threadIdx.x; u < (LDS_BYTES - LDSCTL_OFF) / 4; u += 512) ((LAS unsigned*)(l3 + LDSCTL_OFF))[u] = 0u;
    __syncthreads();
    const XcdBarrier bar = xcd_barrier_post((unsigned*)(kp0->ws + WS_CTL) + CW_BAR, MISC + 8);
#if defined(PROBE_MASK)
    if (threadIdx.x == 0) ((volatile LAS unsigned*)(l3 + MISC_OFF + 64))[0] = (unsigned)__builtin_amdgcn_s_memrealtime();
#endif
    PHASE_BEGIN { Ptrs P; P.x = kq->x; P.a_norm_g = kq->a_norm_g; P.a_w_in = kq->a_w_in; P.a_gn_g = kq->a_gn_g; P.a_w_o = kq->a_w_o; P.a_ffn_norm_g = kq->a_ffn_norm_g; P.a_w_gu = kq->a_w_gu; P.a_w_down = kq->a_w_down;
        P.kv_norm_g = kq->kv_norm_g; P.w_kv = kq->w_kv; P.k_norm_g = kq->k_norm_g; P.b_norm_g = kq->b_norm_g; P.b_w_q = kq->b_w_q; P.b_q_norm_g = kq->b_q_norm_g; P.b_rel_bias = kq->b_rel_bias; P.b_w_o = kq->b_w_o;
        P.b_ffn_norm_g = kq->b_ffn_norm_g; P.b_w_gu = kq->b_w_gu; P.b_w_down = kq->b_w_down; P.out = outp; P.ws = ws;
        prologue_phase(P, (float*)(lds + wave * 16384), bxl * 8 + wave, 256 * 8, tl & 63); } PHASE_END(0)
    PHASE_BEGIN { EpiIn E{F32W(WS_SS0), (const unsigned*)(ws + WS_COS), BFW(WS_Q), BFW(WS_K), BFW(WS_V), BFW(WS_G)};
        gemm_run(l3, (const bf16_t*)outp, BFW(WS_W1), RIN, 1024, E, tl, bxl); } PHASE_END(1)
    PHASE_BEGIN ret::scores_phase(l3, BFW(WS_Q), BFW(WS_K), (bf16_t*)outp + (size_t)32 * MiB, tl, 256, bxl); PHASE_END(2)
    PHASE_BEGIN ret::scan_phase(l3, BFW(WS_Q), BFW(WS_K), BFW(WS_V), BFW(WS_G), (const bf16_t*)outp + (size_t)32 * MiB, F32W(WS_SSH), tl, bxl); PHASE_END(3)
    PROBE_STAMP(4);
    PHASE_BEGIN { EpiRes<true> E{kq->x, nullptr, nullptr, BFW(WS_XH1), F32W(WS_SS1), F32W(WS_SSH)}; gemm_run(l3, BFW(WS_G), BFW(WS_W2), 1024, 2048, E, tl, bxl); } PHASE_END(5)
    PHASE_BEGIN { EpiGU E{F32W(WS_SS1), BFW(WS_H)}; gemm_run(l3, BFW(WS_XH1), BFW(WS_W3), 2 * FF, 1024, E, tl, bxl); } PHASE_END(6)
    PHASE_BEGIN { EpiRes<false> E{nullptr, BFW(WS_XH1), nullptr, BFW(WS_XH2), F32W(WS_SS2), nullptr}; gemm_run(l3, BFW(WS_H), BFW(WS_W4), 1024, FF, E, tl, bxl); } PHASE_END(7)
    PHASE_BEGIN { EpiKVQ E{F32W(WS_SS2), kq->k_norm_g, kq->b_q_norm_g, BFW(WS_K2), BFW(WS_V2), BFW(WS_Q2)}; gemm_run(l3, BFW(WS_XH2), BFW(WS_W5), 3072, 1024, E, tl, bxl); } PHASE_END(8)
    PHASE_BEGIN att::attention_phase(l3, BFW(WS_Q2), BFW(WS_K2), BFW(WS_V2), kq->b_rel_bias, kq->b_q_norm_g, kq->k_norm_g, BFW(WS_O2), tl, bxl); PHASE_END(9)
    PHASE_BEGIN { EpiRes<false> E{nullptr, BFW(WS_XH2), nullptr, BFW(WS_XH3), F32W(WS_SS3), nullptr}; gemm_run(l3, BFW(WS_O2), BFW(WS_W6), 1024, 1024, E, tl, bxl); } PHASE_END(10)
    PHASE_BEGIN { EpiGU E{F32W(WS_SS3), BFW(WS_H)}; gemm_run(l3, BFW(WS_XH3), BFW(WS_W7), 2 * FF, 1024, E, tl, bxl); } PHASE_END(11)
    PHASE_BEGIN { EpiRes<false> E{nullptr, BFW(WS_XH3), outp, nullptr, nullptr, nullptr}; gemm_run(l3, BFW(WS_H), BFW(WS_W8), 1024, FF, E, tl, bxl); } } PROBE_STAMP(12);
#if defined(PROBE_MASK)
    if (blockIdx.x == 0 && threadIdx.x == 0) { volatile LAS unsigned* ts_ = (volatile LAS unsigned*)(l3 + MISC_OFF + 64); unsigned acc_ = 0u;
        for (int k = 0; k < NPH; ++k) if ((PROBE_MASK >> k) & 1) acc_ += ts_[k + 1] - ts_[k];
        const unsigned t_end = (unsigned)__builtin_amdgcn_s_memrealtime(); while ((unsigned)__builtin_amdgcn_s_memrealtime() - t_end < acc_) __builtin_amdgcn_s_sleep(8); }
#endif
}
extern "C" void kernel_launch(void* const* d_in, const int* in_sizes, int n_in, void* d_out, int out_size, void* d_ws, size_t ws_size, hipStream_t stream) {
    if (n_in != 19 || ws_size < WS_END || out_size != MTOK * DM) { fprintf(stderr, "kernel_launch: unexpected shapes (n_in %d, ws %zu, out %d)\n", n_in, ws_size, out_size); return; }
    MArgs a{};
    const float** pp = (const float**)&a.P;
    for (int i = 0; i < 19; ++i) pp[i] = (const float*)d_in[i];
    a.P.out = (float*)d_out; a.P.ws = (unsigned char*)d_ws;
    static int grid = 0;
    if (!grid) {
        if (hipFuncSetAttribute((const void*)mega, hipFuncAttributeMaxDynamicSharedMemorySize, LDS_BYTES) != hipSuccess) fprintf(stderr, "kernel_launch: hipFuncSetAttribute(mega) failed\n");
        int dev = 0, cus = 0, per_cu = 0; (void)hipGetDevice(&dev); (void)hipDeviceGetAttribute(&cus, hipDeviceAttributeMultiprocessorCount, dev);
        (void)hipOccupancyMaxActiveBlocksPerMultiprocessor(&per_cu, (const void*)mega, 512, LDS_BYTES);
        if (per_cu < 1 || cus < 256) fprintf(stderr, "kernel_launch: built for 256 CUs with one 512-thread workgroup each (device: %d CUs, occupancy query %d per CU)\n", cus, per_cu);
        (void)hipGetLastError();
        grid = 256;
    }
    (void)hipMemsetAsync(d_ws, 0, ZERO_BYTES, stream);
    void* args[] = {(void*)&a};
    if (hipLaunchCooperativeKernel((const void*)mega, dim3(grid), dim3(512), args, LDS_BYTES, stream) != hipSuccess) {
        (void)hipGetLastError(); fprintf(stderr, "kernel_launch: cooperative launch refused; plain launch of the same grid\n");
        hipLaunchKernelGGL(mega, dim3(grid), dim3(512), LDS_BYTES, stream, a);
    }
    const hipError_t e = hipPeekAtLastError();
    if (e != hipSuccess) fprintf(stderr, "kernel_launch: launch failed: %s\n", hipGetErrorName(e));
}
```

```cpp
#include <hip/hip_runtime.h>
#include <cstdio>
#include <cstdint>
#include <type_traits>

typedef unsigned short bf16_t;
typedef short bf16x8 __attribute__((ext_vector_type(8)));
typedef float f32x4 __attribute__((ext_vector_type(4)));
typedef float f32x2 __attribute__((ext_vector_type(2)));
typedef unsigned u32x4 __attribute__((ext_vector_type(4)));
typedef unsigned u32x2 __attribute__((ext_vector_type(2)));

constexpr int BATCH = 8, SEQ = 4096, DM = 1024, MTOK = BATCH * SEQ;
constexpr int CH = 64, NCH = SEQ / CH;
constexpr int RH = 4, RDK = 256, RDV = 512, RQC = 1024, RVC = 2048, RIN = 6144;
constexpr int AH = 16, AHD = 64, PAST = 8, RELCLIP = 256, RELT = 513;
constexpr int FF = 2816;
constexpr float EPS = 1e-6f;
constexpr float LOG2E = 1.4426950408889634f;

constexpr size_t MiB = 1u << 20;
constexpr size_t WS_CTL = 0;
constexpr size_t WS_SS1 = 1 * MiB;
constexpr size_t WS_SS2 = WS_SS1 + 128 * 1024;
constexpr size_t WS_SS3 = WS_SS2 + 128 * 1024;
constexpr size_t WS_SSH = 66 * MiB;
constexpr size_t ZERO_BYTES = 2 * MiB;
constexpr size_t WS_SS0 = 2 * MiB;
constexpr size_t WS_COS = 3 * MiB;
constexpr size_t WS_W1 = 8 * MiB, WS_W2 = 20 * MiB, WS_W3 = 24 * MiB, WS_W4 = 35 * MiB, WS_W5 = 41 * MiB, WS_W6 = 47 * MiB, WS_W7 = 49 * MiB, WS_W8 = 60 * MiB;
constexpr size_t WS_Q = 72 * MiB, WS_K = 136 * MiB, WS_V = 200 * MiB, WS_G = 328 * MiB;
constexpr size_t WS_XH1 = 248 * MiB, WS_H = 72 * MiB, WS_XH2 = 328 * MiB;
constexpr size_t WS_K2 = 72 * MiB, WS_V2 = 136 * MiB, WS_Q2 = 200 * MiB, WS_O2 = 264 * MiB, WS_XH3 = 392 * MiB;
constexpr size_t WS_END = 456 * MiB;

struct Ptrs {
    const float *x, *a_norm_g, *a_w_in, *a_gn_g, *a_w_o, *a_ffn_norm_g, *a_w_gu, *a_w_down, *kv_norm_g, *w_kv, *k_norm_g,
                *b_norm_g, *b_w_q, *b_q_norm_g, *b_rel_bias, *b_w_o, *b_ffn_norm_g, *b_w_gu, *b_w_down;
    float* out; unsigned char* ws;
};

__device__ __forceinline__ unsigned f2bf(float f) { unsigned u = __float_as_uint(f); return (u + 0x7fffu + ((u >> 16) & 1u)) >> 16; }
typedef __bf16 bf16x2_t __attribute__((ext_vector_type(2)));
__device__ __forceinline__ unsigned pk2(float lo, float hi) { const f32x2 v = {lo, hi}; const bf16x2_t b = __builtin_convertvector(v, bf16x2_t); return __builtin_bit_cast(unsigned, b); }
__device__ __forceinline__ float bf2f(unsigned short h) { return __uint_as_float((unsigned)h << 16); }
__device__ __forceinline__ float bflo(unsigned w) { return __uint_as_float(w << 16); }
__device__ __forceinline__ float bfhi(unsigned w) { return __uint_as_float(w & 0xffff0000u); }
__device__ __forceinline__ void store8bf(bf16_t* dst, const f32x4 a, const f32x4 b) {
    u32x4 w; w.x = pk2(a[0], a[1]); w.y = pk2(a[2], a[3]); w.z = pk2(b[0], b[1]); w.w = pk2(b[2], b[3]); *(u32x4*)dst = w;
}
template <int MASK> __device__ __forceinline__ float shx(float v) {
    if constexpr (MASK == 32) { const auto r = __builtin_amdgcn_permlane32_swap(__float_as_uint(v), __float_as_uint(v), false, false); return __uint_as_float((threadIdx.x & 32) ? r[0] : r[1]); }
    else return __uint_as_float((unsigned)__builtin_amdgcn_ds_swizzle((int)__float_as_uint(v), 0x1f | (MASK << 10)));
}
template <int MASK> __device__ __forceinline__ float addx(float v) {
    if constexpr (MASK == 32) { const auto r = __builtin_amdgcn_permlane32_swap(__float_as_uint(v), __float_as_uint(v), false, false); return __uint_as_float(r[0]) + __uint_as_float(r[1]); }
    else return v + shx<MASK>(v);
}
template <int MASK> __device__ __forceinline__ float maxx(float v) {
    if constexpr (MASK == 32) { const auto r = __builtin_amdgcn_permlane32_swap(__float_as_uint(v), __float_as_uint(v), false, false); return fmaxf(__uint_as_float(r[0]), __uint_as_float(r[1])); }
    else return fmaxf(v, shx<MASK>(v));
}
__device__ __forceinline__ float rstd_of(float ss, float inv_n) { return __builtin_amdgcn_rsqf(ss * inv_n + EPS); }
__device__ __forceinline__ float silu_f(float g) { return g * __builtin_amdgcn_rcpf(1.f + __builtin_amdgcn_exp2f(-LOG2E * g)); }

enum { MAP_ID = 0, MAP_WIN = 1, MAP_GU = 2, MAP_HEAD = 3 };
struct TrItem { const float* W; int K, Nsrc; bf16_t* WT; int dst_row_off; const float* gain; int map, src_off, Ndst, item; };
__device__ __forceinline__ TrItem tr_decode(const Ptrs& P, int it) {
    unsigned char* ws = P.ws;
    constexpr int I1 = 16 * 192, I2 = 32 * 32, I3 = 16 * 176, I4 = 44 * 32, I5 = 16 * 32, I6 = 16 * 32;
    int r = it;
    if (r < I1) return TrItem{P.a_w_in, 1024, RIN, (bf16_t*)(ws + WS_W1), 0, P.a_norm_g, MAP_WIN, 0, RIN, r}; r -= I1;
    if (r < I2) return TrItem{P.a_w_o, 2048, 1024, (bf16_t*)(ws + WS_W2), 0, P.a_gn_g, MAP_ID, 0, 1024, r}; r -= I2;
    if (r < I3) return TrItem{P.a_w_gu, 1024, 2 * FF, (bf16_t*)(ws + WS_W3), 0, P.a_ffn_norm_g, MAP_GU, 0, 2 * FF, r}; r -= I3;
    if (r < I4) return TrItem{P.a_w_down, FF, 1024, (bf16_t*)(ws + WS_W4), 0, nullptr, MAP_ID, 0, 1024, r}; r -= I4;
    if (r < I5) return TrItem{P.w_kv, 1024, 2048, (bf16_t*)(ws + WS_W5), 0, P.kv_norm_g, MAP_HEAD, 0, 1024, r}; r -= I5;
    if (r < I5) return TrItem{P.w_kv, 1024, 2048, (bf16_t*)(ws + WS_W5), 1024, P.kv_norm_g, MAP_ID, 1024, 1024, r}; r -= I5;
    if (r < I5) return TrItem{P.b_w_q, 1024, 1024, (bf16_t*)(ws + WS_W5), 2048, P.b_norm_g, MAP_HEAD, 0, 1024, r}; r -= I5;
    if (r < I6) return TrItem{P.b_w_o, 1024, 1024, (bf16_t*)(ws + WS_W6), 0, nullptr, MAP_ID, 0, 1024, r}; r -= I6;
    if (r < I3) return TrItem{P.b_w_gu, 1024, 2 * FF, (bf16_t*)(ws + WS_W7), 0, P.b_ffn_norm_g, MAP_GU, 0, 2 * FF, r}; r -= I3;
    return TrItem{P.b_w_down, FF, 1024, (bf16_t*)(ws + WS_W8), 0, nullptr, MAP_ID, 0, 1024, r};
}
__device__ __forceinline__ void tr_load(const TrItem& T, int lane, f32x4 (&wv)[8], float (&gv)[8]) {
    const int nblk = T.Ndst / 32, kb = T.item / nblk, nb = T.item % nblk, k0 = 64 * kb, n0 = 32 * nb;
    int src; float cs = 1.f;
    if (T.map == MAP_GU) { const int pn = n0 >> 8, c = n0 & 255; src = c < 128 ? 128 * pn + c : FF + 128 * pn + (c - 128); }
    else if (T.map == MAP_HEAD) { const int pn = n0 >> 8, c = n0 & 255, bj = c >> 7, wc = (c & 127) >> 5; src = T.src_off + 256 * pn + 64 * wc + 32 * bj; }
    else { src = T.src_off + n0; if (T.map == MAP_WIN && n0 >= 1024 && n0 < 2048) cs = 0.0625f; }
    const int rsub = lane >> 3, c4 = (lane & 7) * 4;
#pragma unroll
    for (int i = 0; i < 8; ++i) { const int kk = 8 * i + rsub; wv[i] = *(const f32x4*)(T.W + (size_t)(k0 + kk) * T.Nsrc + src + c4); gv[i] = T.gain ? T.gain[k0 + kk] * cs : cs; }
}
__device__ __forceinline__ void tr_finish(const TrItem& T, int lane, const f32x4 (&wv)[8], const float (&gv)[8], float* scr) {
    const int nblk = T.Ndst / 32, kb = T.item / nblk, nb = T.item % nblk, k0 = 64 * kb, n0 = 32 * nb;
    { const int rsub = lane >> 3, c4 = (lane & 7) * 4;
#pragma unroll
      for (int i = 0; i < 8; ++i) { float* d = scr + (8 * i + rsub) * 33 + c4; d[0] = wv[i][0] * gv[i]; d[1] = wv[i][1] * gv[i]; d[2] = wv[i][2] * gv[i]; d[3] = wv[i][3] * gv[i]; } }
    __builtin_amdgcn_s_waitcnt(0xc07f); asm volatile("" ::: "memory");
    const int c = lane & 7;
#pragma unroll
    for (int j = 0; j < 4; ++j) { const int n = (lane >> 3) + 8 * j; const float* sp = scr + (8 * c) * 33 + n;
        u32x4 o; o.x = pk2(sp[0 * 33], sp[1 * 33]); o.y = pk2(sp[2 * 33], sp[3 * 33]); o.z = pk2(sp[4 * 33], sp[5 * 33]); o.w = pk2(sp[6 * 33], sp[7 * 33]);
        *(u32x4*)(T.WT + (size_t)(T.dst_row_off + n0 + n) * T.K + k0 + 8 * c) = o; }
    __builtin_amdgcn_s_waitcnt(0xc07f); asm volatile("" ::: "memory");
}
__device__ __forceinline__ float wave_sum(float v) { v = addx<1>(v); v = addx<2>(v); v = addx<4>(v); v = addx<8>(v); v = addx<16>(v); return addx<32>(v); }
__device__ __forceinline__ void prologue_phase(const Ptrs& P, float* scr, int gw, int NGW, int lane) {
    unsigned char* ws = P.ws;
    constexpr int NITEMS = 16 * 192 + 32 * 32 + 2 * (16 * 176) + 2 * (44 * 32) + 3 * (16 * 32) + 16 * 32;
    {   f32x4 wvA[8], wvB[8]; float gvA[8], gvB[8];
        int it = gw;
        if (it < NITEMS) { TrItem TA = tr_decode(P, it); tr_load(TA, lane, wvA, gvA);
            for (;;) {
                const int itB = it + NGW; TrItem TB = tr_decode(P, itB < NITEMS ? itB : it);
                if (itB < NITEMS) tr_load(TB, lane, wvB, gvB);
                tr_finish(TA, lane, wvA, gvA, scr);
                if (itB >= NITEMS) break;
                const int itA = itB + NGW; TA = tr_decode(P, itA < NITEMS ? itA : itB);
                if (itA < NITEMS) tr_load(TA, lane, wvA, gvA);
                tr_finish(TB, lane, wvB, gvB, scr);
                if (itA >= NITEMS) break;
                it = itA;
            } }
    }
    bf16_t* xh0 = (bf16_t*)P.out; float* ss0 = (float*)(ws + WS_SS0);
    {   f32x4 vA[4][4], vB[4][4];
#define XP_LOAD(v, m0) do { _Pragma("unroll") for (int r = 0; r < 4; ++r) { const f32x4* xr = (const f32x4*)(P.x + (size_t)((m0) + r) * DM) + lane; _Pragma("unroll") for (int j = 0; j < 4; ++j) v[r][j] = xr[64 * j]; } } while (0)
#define XP_FIN(v, m0) do { float sq[4]; \
        _Pragma("unroll") for (int r = 0; r < 4; ++r) { float a_ = 0.f; \
            _Pragma("unroll") for (int j = 0; j < 4; ++j) a_ += (v[r][j][0] * v[r][j][0] + v[r][j][1] * v[r][j][1]) + (v[r][j][2] * v[r][j][2] + v[r][j][3] * v[r][j][3]); sq[r] = wave_sum(a_); } \
        _Pragma("unroll") for (int r = 0; r < 4; ++r) { u32x2* o = (u32x2*)(xh0 + (size_t)((m0) + r) * DM) + lane; \
            _Pragma("unroll") for (int j = 0; j < 4; ++j) { u32x2 w; w.x = pk2(v[r][j][0], v[r][j][1]); w.y = pk2(v[r][j][2], v[r][j][3]); o[64 * j] = w; } \
            if (lane == 0) ss0[(m0) + r] = sq[r]; } } while (0)
        const int step = NGW * 4;
        XP_LOAD(vA, gw * 4);
        for (int m0 = gw * 4; m0 < MTOK; m0 += 2 * step) {
            XP_LOAD(vB, m0 + step);
            XP_FIN(vA, m0);
            XP_LOAD(vA, (m0 + 2 * step < MTOK ? m0 + 2 * step : m0));
            XP_FIN(vB, m0 + step);
        }
#undef XP_LOAD
#undef XP_FIN
    }
    unsigned* rcs = (unsigned*)(ws + WS_COS);
    if ((gw & 3) == 0 && (gw >> 2) < 512) {
        const int e = (gw >> 2) * 64 + lane, i = e & 127, pb = e >> 7;
        double th = 1.0; { double bb = 0.9305720409296989792906463164991; int k = i; while (k) { if (k & 1) th *= bb; bb *= bb; k >>= 1; } }
        double c1, s1; { const double t2 = th * th;
            double cs = 1.0 / 2432902008176640000.0; cs = cs * t2 - 1.0 / 6402373705728000.0; cs = cs * t2 + 1.0 / 20922789888000.0; cs = cs * t2 - 1.0 / 87178291200.0; cs = cs * t2 + 1.0 / 479001600.0;
            cs = cs * t2 - 1.0 / 3628800.0; cs = cs * t2 + 1.0 / 40320.0; cs = cs * t2 - 1.0 / 720.0; cs = cs * t2 + 1.0 / 24.0; cs = cs * t2 - 0.5; c1 = cs * t2 + 1.0;
            double sn = 1.0 / 51090942171709440000.0; sn = sn * t2 - 1.0 / 121645100408832000.0; sn = sn * t2 + 1.0 / 355687428096000.0; sn = sn * t2 - 1.0 / 1307674368000.0; sn = sn * t2 + 1.0 / 6227020800.0;
            sn = sn * t2 - 1.0 / 39916800.0; sn = sn * t2 + 1.0 / 362880.0; sn = sn * t2 - 1.0 / 5040.0; sn = sn * t2 + 1.0 / 120.0; sn = sn * t2 - 1.0 / 6.0; s1 = (sn * t2 + 1.0) * th; }
        double cc = 1.0, sc = 0.0; { double bc = c1, bs = s1; int k = 16 * pb;
            while (k) { if (k & 1) { const double nc = cc * bc - sc * bs, ns = cc * bs + sc * bc; cc = nc; sc = ns; }
                const double c2 = bc * bc - bs * bs, s2 = 2.0 * bc * bs; bc = c2; bs = s2; k >>= 1; } }
#pragma unroll 4
        for (int p = 0; p < 16; ++p) { const int pos = pb * 16 + p; const _Float16 hc_ = (_Float16)(float)cc, hs_ = (_Float16)(float)sc;
            rcs[pos * 128 + i] = (unsigned)__builtin_bit_cast(unsigned short, hc_) | ((unsigned)__builtin_bit_cast(unsigned short, hs_) << 16);
            const double nc = cc * c1 - sc * s1, ns = cc * s1 + sc * c1; cc = nc; sc = ns; }
    }
}

__device__ __forceinline__ float ret_l2g(int h) { return h == 0 ? -0.04580368961312479f : h == 1 ? -0.02272007650008353f : h == 2 ? -0.011315313227834146f : -0.005646563141142063f; }
__device__ __forceinline__ float ret_pfac(float l2g, int t, int s) { return exp2f(l2g * (float)(t >= s ? -64 : 2 * (s - t) - 64)); }

#define PG8_LAS_ __attribute__((address_space(3)))
namespace pg8 { struct Unit { int pm, pn; }; }
struct NoLoad {};
struct EpiIn {
    static constexpr bool PERM = true, AFTER_DRAIN = false, KHOOK = false; static constexpr int HB = 4;
    const float* ss; const unsigned* rcs; bf16_t *Q, *K, *V, *G;
    struct Light { float ssv; };
    struct Heavy { u32x4 t0, t1; };
    __device__ __forceinline__ Light lpre(int row, int pn, int wc, int fq) const { Light p; p.ssv = ss[row]; return p; }
    __device__ __forceinline__ Heavy hpre(int row, int pn, int wc, int fq) const {
        Heavy p;
        if (pn < 8) { const int pos = row & (SEQ - 1), c8 = wc * 32 + fq * 8;
            p.t0 = *(const u32x4*)(rcs + pos * 128 + c8); p.t1 = *(const u32x4*)(rcs + pos * 128 + c8 + 4); }
        else { p.t0 = p.t1 = (u32x4){0u, 0u, 0u, 0u}; }
        return p;
    }
    typedef NoLoad UPre;
    __device__ __forceinline__ UPre upre(int pn, int wc, int fq) const { return UPre{}; }
    __device__ __forceinline__ void fin(int row, int pn, int wc, int fq, const f32x4 (&v)[2][2], const Light& l, const Heavy& p, const UPre&) const {
        const float rs = rstd_of(l.ssv, 1.f / 1024.f);
        const int c8 = wc * 32 + fq * 8;
        const f32x4 a0 = v[0][0] * rs, a1 = v[0][1] * rs, b0 = v[1][0] * rs, b1 = v[1][1] * rs;
        struct CS { f32x4 c0, c1, s0, s1; } q;
        if (pn < 8) {
#define H2F(w, hi) ((float)__builtin_bit_cast(_Float16, (unsigned short)((hi) ? ((w) >> 16) : ((w) & 0xffffu))))
            q.c0 = (f32x4){H2F(p.t0.x, 0), H2F(p.t0.y, 0), H2F(p.t0.z, 0), H2F(p.t0.w, 0)}; q.s0 = (f32x4){H2F(p.t0.x, 1), H2F(p.t0.y, 1), H2F(p.t0.z, 1), H2F(p.t0.w, 1)};
            q.c1 = (f32x4){H2F(p.t1.x, 0), H2F(p.t1.y, 0), H2F(p.t1.z, 0), H2F(p.t1.w, 0)}; q.s1 = (f32x4){H2F(p.t1.x, 1), H2F(p.t1.y, 1), H2F(p.t1.z, 1), H2F(p.t1.w, 1)};
#undef H2F
        }
        if (pn < 4) {
            bf16_t* dst = Q + (size_t)row * 1024 + pn * 256 + wc * 32 + 16 * (fq & 1) + 4 * (fq >> 1);
            const f32x4 r0 = a0 * q.c0 - b0 * q.s0, r1 = a1 * q.c1 - b1 * q.s1, i0 = a0 * q.s0 + b0 * q.c0, i1 = a1 * q.s1 + b1 * q.c1;
            u32x2 w; w.x = pk2(r0[0], r0[1]); w.y = pk2(r0[2], r0[3]); *(u32x2*)dst = w; w.x = pk2(r1[0], r1[1]); w.y = pk2(r1[2], r1[3]); *(u32x2*)(dst + 8) = w;
            w.x = pk2(i0[0], i0[1]); w.y = pk2(i0[2], i0[3]); *(u32x2*)(dst + 128) = w; w.x = pk2(i1[0], i1[1]); w.y = pk2(i1[2], i1[3]); *(u32x2*)(dst + 136) = w;
        } else if (pn < 8) {
            bf16_t* dst = K + (size_t)row * 1024 + (pn & 3) * 256 + c8;
            store8bf(dst, a0 * q.c0 - b0 * q.s0, a1 * q.c1 - b1 * q.s1);
            store8bf(dst + 128, a0 * q.s0 + b0 * q.c0, a1 * q.s1 + b1 * q.c1);
        } else if (pn < 16) {
            bf16_t* dst = V + (size_t)row * 2048 + (pn - 8) * 256 + c8;
            const float kd = exp2f(ret_l2g((pn - 8) >> 1) * (float)(63 - (row & 63)));
            store8bf(dst, a0 * kd, a1 * kd); store8bf(dst + 128, b0 * kd, b1 * kd);
        } else {
            bf16_t* dst = G + (size_t)row * 2048 + (pn - 16) * 256 + c8;
            f32x4 g[4] = {a0, a1, b0, b1};
#pragma unroll
            for (int i = 0; i < 4; ++i)
#pragma unroll
                for (int e = 0; e < 4; ++e) g[i][e] = silu_f(g[i][e]);
            store8bf(dst, g[0], g[1]); store8bf(dst + 128, g[2], g[3]);
        }
    }
};
template <bool F32BASE> struct EpiRes {
    static constexpr bool PERM = false, AFTER_DRAIN = false, KHOOK = F32BASE; static constexpr int HB = 4;
    const float* basef; const bf16_t* baseh; float* out; bf16_t* xh; float* ss; const float* ssh;
    static constexpr int TAB_OFF = 131072 + 1024;
    template <class Sched> __device__ __forceinline__ void hook_fill(PG8_LAS_ unsigned char* lds, const Sched& S, int tid) const {
        pg8::Unit u; const int i = tid >> 8, rl = tid & 255;
        if (S.next(i, u)) { const float* p = ssh + (size_t)(u.pm * 256 + rl) * 32; float r[4];
#pragma unroll
            for (int h = 0; h < 4; ++h) { const f32x4 a = *(const f32x4*)(p + 8 * h), b = *(const f32x4*)(p + 8 * h + 4); r[h] = rstd_of(((a[0] + a[1]) + (a[2] + a[3])) + ((b[0] + b[1]) + (b[2] + b[3])), 1.f / 512.f); }
            *(PG8_LAS_ f32x4*)(lds + TAB_OFF + i * 4096 + rl * 16) = (f32x4){r[0] * __builtin_amdgcn_rcpf(r[1]), r[1] * __builtin_amdgcn_rcpf(r[2]), r[2] * __builtin_amdgcn_rcpf(r[3]), r[3]}; }
    }
    __device__ __forceinline__ void hook_scale(f32x4 (&acc)[2][2][4][2], PG8_LAS_ unsigned char* lds, int ui, int idx, int wr) const {
        int l2_; asm volatile("v_mbcnt_lo_u32_b32 %0, -1, 0\n\tv_mbcnt_hi_u32_b32 %0, -1, %0" : "=v"(l2_));
        const PG8_LAS_ float* tb = (const PG8_LAS_ float*)(lds + TAB_OFF + (ui & 1) * 4096) + idx + (wr * 64 + (l2_ & 15)) * 4;
#pragma unroll
        for (int ai = 0; ai < 2; ++ai)
#pragma unroll
            for (int m = 0; m < 4; ++m) { const float rho = tb[(128 * ai + 16 * m) * 4];
#pragma unroll
                for (int bj = 0; bj < 2; ++bj)
#pragma unroll
                    for (int n = 0; n < 2; ++n) acc[ai][bj][m][n] = acc[ai][bj][m][n] * rho; }
    }
    struct LightH { u32x2 b[2][2]; };
    struct HeavyF { f32x4 b[2][2]; };
    typedef typename std::conditional<F32BASE, NoLoad, LightH>::type Light;
    typedef typename std::conditional<F32BASE, HeavyF, NoLoad>::type Heavy;
    __device__ __forceinline__ Light lpre(int row, int pn, int wc, int fq) const {
        Light p;
        if constexpr (!F32BASE) { const size_t off0 = (size_t)row * DM + pn * 256 + wc * 32 + 4 * fq;
#pragma unroll
            for (int bj = 0; bj < 2; ++bj)
#pragma unroll
                for (int n = 0; n < 2; ++n) p.b[bj][n] = *(const u32x2*)(baseh + off0 + bj * 128 + n * 16); }
        return p;
    }
    __device__ __forceinline__ Heavy hpre(int row, int pn, int wc, int fq) const {
        Heavy p;
        if constexpr (F32BASE) { const size_t off0 = (size_t)row * DM + pn * 256 + wc * 32 + 4 * fq;
#pragma unroll
            for (int bj = 0; bj < 2; ++bj)
#pragma unroll
                for (int n = 0; n < 2; ++n) p.b[bj][n] = *(const f32x4*)(basef + off0 + bj * 128 + n * 16); }
        return p;
    }
    typedef NoLoad UPre;
    __device__ __forceinline__ UPre upre(int pn, int wc, int fq) const { return UPre{}; }
    __device__ __forceinline__ void fin(int row, int pn, int wc, int fq, const f32x4 (&v)[2][2], const Light& l, const Heavy& p, const UPre&) const {
        const size_t off0 = (size_t)row * DM + pn * 256 + wc * 32 + 4 * fq; float part = 0.f;
#pragma unroll
        for (int bj = 0; bj < 2; ++bj)
#pragma unroll
            for (int n = 0; n < 2; ++n) { const size_t off = off0 + bj * 128 + n * 16;
                f32x4 bs;
                if constexpr (F32BASE) bs = p.b[bj][n]; else bs = (f32x4){bflo(l.b[bj][n].x), bfhi(l.b[bj][n].x), bflo(l.b[bj][n].y), bfhi(l.b[bj][n].y)};
                const f32x4 x = bs + v[bj][n];
                if (out) *(f32x4*)(out + off) = x;
                if (xh) { u32x2 w; w.x = pk2(x[0], x[1]); w.y = pk2(x[2], x[3]); *(u32x2*)(xh + off) = w; }
                part += (x[0] * x[0] + x[1] * x[1]) + (x[2] * x[2] + x[3] * x[3]); }
        if (ss) { part = addx<16>(part); part = addx<32>(part); if (fq == 0) atomicAdd(ss + row, part); }
    }
};
struct EpiResP {
    static constexpr bool PERM = true, AFTER_DRAIN = false, KHOOK = false; static constexpr int HB = 4;
    const bf16_t* baseh; float* out; bf16_t* xh; float* ss;
    struct Light { u32x4 b[2]; };
    typedef NoLoad Heavy;
    typedef NoLoad UPre;
    __device__ __forceinline__ Light lpre(int row, int pn, int wc, int fq) const {
        Light p; const size_t off0 = (size_t)row * DM + pn * 256 + wc * 32 + 8 * fq;
#pragma unroll
        for (int bj = 0; bj < 2; ++bj) p.b[bj] = *(const u32x4*)(baseh + off0 + bj * 128);
        return p;
    }
    __device__ __forceinline__ Heavy hpre(int row, int pn, int wc, int fq) const { return Heavy{}; }
    __device__ __forceinline__ UPre upre(int pn, int wc, int fq) const { return UPre{}; }
    __device__ __forceinline__ void fin(int row, int pn, int wc, int fq, const f32x4 (&v)[2][2], const Light& l, const Heavy&, const UPre&) const {
        const size_t off0 = (size_t)row * DM + pn * 256 + wc * 32 + 8 * fq; float part = 0.f;
#pragma unroll
        for (int bj = 0; bj < 2; ++bj) { const size_t off = off0 + bj * 128;
            const f32x4 b0 = (f32x4){bflo(l.b[bj].x), bfhi(l.b[bj].x), bflo(l.b[bj].y), bfhi(l.b[bj].y)}, b1 = (f32x4){bflo(l.b[bj].z), bfhi(l.b[bj].z), bflo(l.b[bj].w), bfhi(l.b[bj].w)};
            const f32x4 x0 = b0 + v[bj][0], x1 = b1 + v[bj][1];
            if (out) { *(f32x4*)(out + off) = x0; *(f32x4*)(out + off + 4) = x1; }
            if (xh) store8bf(xh + off, x0, x1);
            part += ((x0[0] * x0[0] + x0[1] * x0[1]) + (x0[2] * x0[2] + x0[3] * x0[3])) + ((x1[0] * x1[0] + x1[1] * x1[1]) + (x1[2] * x1[2] + x1[3] * x1[3])); }
        if (ss) { part = addx<16>(part); part = addx<32>(part); if (fq == 0) atomicAdd(ss + row, part); }
    }
};
struct EpiGU {
    static constexpr bool PERM = true, AFTER_DRAIN = false, KHOOK = false; static constexpr int HB = 4;
    const float* ss; bf16_t* H;
    struct Light { float ssv; };
    typedef NoLoad Heavy;
    __device__ __forceinline__ Light lpre(int row, int pn, int wc, int fq) const { Light p; p.ssv = ss[row]; return p; }
    __device__ __forceinline__ Heavy hpre(int row, int pn, int wc, int fq) const { return Heavy{}; }
    typedef NoLoad UPre;
    __device__ __forceinline__ UPre upre(int pn, int wc, int fq) const { return UPre{}; }
    __device__ __forceinline__ void fin(int row, int pn, int wc, int fq, const f32x4 (&v)[2][2], const Light& l, const Heavy&, const UPre&) const {
        const float rs = rstd_of(l.ssv, 1.f / 1024.f);
        f32x4 h[2];
#pragma unroll
        for (int n = 0; n < 2; ++n)
#pragma unroll
            for (int e = 0; e < 4; ++e) { const float g = v[0][n][e] * rs, u = v[1][n][e] * rs; h[n][e] = silu_f(g) * u; }
        store8bf(H + (size_t)row * FF + pn * 128 + wc * 32 + fq * 8, h[0], h[1]);
    }
};
struct EpiKVQ {
    static constexpr bool PERM = true, AFTER_DRAIN = false, KHOOK = false; static constexpr int HB = 4;
    const float* ss; const float* kg; const float* qg; bf16_t *K2, *V2, *Q2;
    struct Light { float ssv; };
    typedef NoLoad Heavy;
    __device__ __forceinline__ Light lpre(int row, int pn, int wc, int fq) const { Light p; p.ssv = ss[row]; return p; }
    __device__ __forceinline__ Heavy hpre(int row, int pn, int wc, int fq) const { return Heavy{}; }
    struct UPre { f32x4 g[2][2]; };
    __device__ __forceinline__ UPre upre(int pn, int wc, int fq) const {
        UPre u; const int t = pn >> 2; const float sc = (t == 2 ? 0.125f * LOG2E : 1.f); const float* gp = (t == 0 ? kg : qg) + fq * 8;
#pragma unroll
        for (int bj = 0; bj < 2; ++bj) { u.g[bj][0] = (t == 1) ? (f32x4){1.f, 1.f, 1.f, 1.f} : *(const f32x4*)(gp + 32 * bj) * sc; u.g[bj][1] = (t == 1) ? (f32x4){1.f, 1.f, 1.f, 1.f} : *(const f32x4*)(gp + 32 * bj + 4) * sc; }
        return u;
    }
    __device__ __forceinline__ void fin(int row, int pn, int wc, int fq, const f32x4 (&v)[2][2], const Light& l, const Heavy&, const UPre& up) const {
        const float rs = rstd_of(l.ssv, 1.f / 1024.f);
        const int t = pn >> 2, pl = pn & 3;
        f32x4 x[2][2]; float s = 0.f;
#pragma unroll
        for (int bj = 0; bj < 2; ++bj)
#pragma unroll
            for (int n = 0; n < 2; ++n) { x[bj][n] = v[bj][n] * rs; s += (x[bj][n][0] * x[bj][n][0] + x[bj][n][1] * x[bj][n][1]) + (x[bj][n][2] * x[bj][n][2] + x[bj][n][3] * x[bj][n][3]); }
        if (t == 1) {
            bf16_t* dst = V2 + (size_t)row * 1024 + pl * 256 + wc * 32 + fq * 8;
            store8bf(dst, x[0][0], x[0][1]); store8bf(dst + 128, x[1][0], x[1][1]);
        } else {
            s = addx<16>(s); s = addx<32>(s);
            const float rh = rstd_of(s, 1.f / 64.f);
            bf16_t* dst = (t == 0 ? K2 : Q2) + (size_t)row * 1024 + (4 * pl + wc) * 64 + fq * 8;
#pragma unroll
            for (int bj = 0; bj < 2; ++bj) store8bf(dst + 32 * bj, x[bj][0] * up.g[bj][0] * rh, x[bj][1] * up.g[bj][1] * rh);
        }
    }
};

namespace pg8 {
#define PG8_LAS __attribute__((address_space(3)))
typedef unsigned short bf16_t;
typedef short bf16x8 __attribute__((ext_vector_type(8)));
typedef float f32x4 __attribute__((ext_vector_type(4)));
typedef unsigned u32x4 __attribute__((ext_vector_type(4)));
constexpr int BM = 256, BK = 64, HALF = 128, HTB = HALF * BK * 2  , STAGE_BYTES = 8 * HTB, NXCD = 8, WGM = 8;

__host__ __device__ __forceinline__ int lds_byte(int r, int c) { const int st = (r >> 4) * 2 + (c >> 5), rr = r & 15, cc = c & 31, ob = rr * 64 + cc * 2; return st * 1024 + (ob ^ (((ob >> 9) & 1) << 5)); }
__host__ __device__ __forceinline__ void stage_rc(int b, int& R, int& C) { const int st = b / 1024, sb = b % 1024, swz = sb ^ (((sb >> 9) & 1) << 5); R = (st >> 1) * 16 + swz / 64; C = (st & 1) * 32 + (swz % 64) / 2; }
__host__ __device__ __forceinline__ int perm32(int rho) { const int n = rho >> 4, i = rho & 15; return 8 * (i >> 2) + 4 * n + (i & 3); }

struct Gemm { const bf16_t* A; const bf16_t* Bt; int M, N, K; };

struct StaticOrder {
    int nM, nN, nwg, G, c;
    __host__ __device__ void init(int M, int N, int G_, int c_) { nM = M / BM; nN = N / BM; nwg = nM * nN; G = G_; c = c_; }
    __host__ __device__ bool next(int i, Unit& u) const {
        const long L = (long)i * G + c; if (L >= nwg) return false;
        int wgid = (int)L; { const int q = nwg / NXCD, r = nwg % NXCD, xcd = wgid % NXCD, off = wgid / NXCD; wgid = (xcd < r ? xcd * (q + 1) : r * (q + 1) + (xcd - r) * q) + off; }
        const int nig = WGM * nN, gid = wgid / nig, fm = gid * WGM, gsz = (nM - fm) < WGM ? (nM - fm) : WGM;
        u.pm = fm + ((wgid % nig) % gsz); u.pn = (wgid % nig) / gsz; return true;
    }
    __device__ __forceinline__ void a_ready(const Unit&) const {}
    __device__ __forceinline__ void done(const Unit&) const {}
};
__device__ __forceinline__ unsigned cvt_pk_bf16(float lo, float hi) { unsigned r; asm volatile("v_cvt_pk_bf16_f32 %0, %1, %2" : "=v"(r) : "v"(lo), "v"(hi)); return r; }

template <class Epi> __device__ __forceinline__ void run_epi(const Epi& E, const f32x4 (&acc)[2][2][4][2], const Unit& u, int wr, int wc, int fr, int fq) {
    const typename Epi::UPre up = E.upre(u.pn, wc, fq);
    typename Epi::Light lp[2][4];
#pragma unroll
    for (int ai = 0; ai < 2; ++ai)
#pragma unroll
        for (int m = 0; m < 4; ++m) lp[ai][m] = E.lpre(u.pm * BM + ai * HALF + wr * 64 + m * 16 + fr, u.pn, wc, fq);
#pragma unroll
    for (int b0 = 0; b0 < 8; b0 += Epi::HB) {
        typename Epi::Heavy hp[Epi::HB];
#pragma unroll
        for (int j = 0; j < Epi::HB; ++j) { const int ai = (b0 + j) >> 2, m = (b0 + j) & 3; hp[j] = E.hpre(u.pm * BM + ai * HALF + wr * 64 + m * 16 + fr, u.pn, wc, fq); }
#pragma unroll
        for (int j = 0; j < Epi::HB; ++j) { const int ai = (b0 + j) >> 2, m = (b0 + j) & 3;
            const f32x4 v[2][2] = {{acc[ai][0][m][0], acc[ai][0][m][1]}, {acc[ai][1][m][0], acc[ai][1][m][1]}};
            E.fin(u.pm * BM + ai * HALF + wr * 64 + m * 16 + fr, u.pn, wc, fq, v, lp[ai][m], hp[j], up);
        }
        asm volatile("" ::: "memory");
    }
}
template <class Epi, class Sched, bool ALIGN_EPI = false, bool SP2 = false>
__device__ __forceinline__ void gemm_phase(PG8_LAS unsigned char* lds, const Gemm g, const Sched& S, const Epi& E, const int tid) {
    const int wid = __builtin_amdgcn_readfirstlane(tid >> 6), lane = tid & 63, wr = wid >> 2, wc = wid & 3, fr = lane & 15, fq = lane >> 4;
    const int K = g.K, nt = K / BK;
    unsigned voffA[2], voffB[2];
#pragma unroll
    for (int i = 0; i < 2; ++i) { int R, C; stage_rc(tid * 16 + i * 8192, R, C); const int Rb = Epi::PERM ? ((R & ~31) + perm32(R & 31)) : R;
        voffA[i] = (unsigned)(R * K + C) * 2u; voffB[i] = (unsigned)(Rb * K + C) * 2u; }
    const size_t kstep = (size_t)(BK * 2);
    const size_t hstep = (size_t)HALF * K * 2;
    const size_t tstep = 2 * hstep;
    const unsigned ldsw = (unsigned)wid * 1024u;
    const int aoff = lds_byte(wr * 64 + fr, fq * 8), boff = lds_byte(wc * 32 + fr, fq * 8);
#define PG8_SA(b, h) (((b) * 2 + (h)) * HTB)
#define PG8_SB(b, h) ((4 + (b) * 2 + (h)) * HTB)
#define PG8_STAGE(bufoff, gbase, voff) do { _Pragma("unroll") for (int _i = 0; _i < 2; ++_i) \
        __builtin_amdgcn_global_load_lds((const unsigned*)((const char*)(gbase) + (voff)[_i]), (PG8_LAS unsigned*)(lds + (bufoff) + ldsw + _i * 8192), 16, 0, 0); } while (0)
#define PG8_LDA(dst, b, h) do { _Pragma("unroll") for (int m = 0; m < 4; ++m) _Pragma("unroll") for (int k = 0; k < 2; ++k) dst[m][k] = *(const PG8_LAS bf16x8*)(lds + PG8_SA(b, h) + aoff + m * 2048 + k * 1024); } while (0)
#define PG8_LDB(dst, b, h) do { _Pragma("unroll") for (int n = 0; n < 2; ++n) _Pragma("unroll") for (int k = 0; k < 2; ++k) dst[n][k] = *(const PG8_LAS bf16x8*)(lds + PG8_SB(b, h) + boff + n * 2048 + k * 1024); } while (0)
#define PG8_MMA(ai, bj, At, Bt) do { __builtin_amdgcn_s_setprio(1); _Pragma("unroll") for (int m = 0; m < 4; ++m) _Pragma("unroll") for (int n = 0; n < 2; ++n) _Pragma("unroll") for (int k = 0; k < 2; ++k) \
        acc[ai][bj][m][n] = __builtin_amdgcn_mfma_f32_16x16x32_bf16(Bt[n][k], At[m][k], acc[ai][bj][m][n], 0, 0, 0); __builtin_amdgcn_s_setprio(0); } while (0)
#define PG8_WAIT_V(n) asm volatile("s_waitcnt vmcnt(" #n ")" ::: "memory")
#define PG8_WAIT_L(n) asm volatile("s_waitcnt lgkmcnt(" #n ")" ::: "memory")
#define PG8_BAR __builtin_amdgcn_s_barrier()
#define PG8_SCHED __builtin_amdgcn_sched_barrier(0)
    Unit cur, nxt; int ui = 0;
    if (!S.next(0, cur)) return;
    f32x4 acc[2][2][4][2];
#pragma unroll
    for (int a = 0; a < 2; ++a)
#pragma unroll
        for (int b = 0; b < 2; ++b)
#pragma unroll
            for (int m = 0; m < 4; ++m)
#pragma unroll
                for (int n = 0; n < 2; ++n) acc[a][b][m][n] = (f32x4){0.f, 0.f, 0.f, 0.f};
    bf16x8 At[4][2], B0[2][2], B1[2][2];
    const char* cA = (const char*)g.A + (size_t)cur.pm * tstep; const char* cB = (const char*)g.Bt + (size_t)cur.pn * tstep;
    S.a_ready(cur);
    if constexpr (Epi::KHOOK) { E.hook_fill(lds, S, tid); asm volatile("s_waitcnt lgkmcnt(0)" ::: "memory"); PG8_BAR; asm volatile("" ::: "memory"); }
    if constexpr (SP2) {
        PG8_STAGE(PG8_SB(0, 0), cB, voffB); PG8_STAGE(PG8_SB(0, 1), cB + hstep, voffB); PG8_STAGE(PG8_SA(0, 0), cA, voffA); PG8_STAGE(PG8_SA(0, 1), cA + hstep, voffA);
        if (wr == 1) PG8_BAR;
        PG8_WAIT_V(2); PG8_BAR;
        PG8_STAGE(PG8_SB(1, 0), cB + kstep, voffB); PG8_STAGE(PG8_SA(1, 0), cA + kstep, voffA); PG8_STAGE(PG8_SB(1, 1), cB + hstep + kstep, voffB);
        PG8_WAIT_V(6); PG8_BAR;
    } else {
        PG8_STAGE(PG8_SB(0, 0), cB, voffB); PG8_STAGE(PG8_SA(0, 0), cA, voffA); PG8_STAGE(PG8_SB(0, 1), cB + hstep, voffB); PG8_STAGE(PG8_SA(0, 1), cA + hstep, voffA);
        if (wr == 1) PG8_BAR;
        PG8_WAIT_V(4); PG8_BAR;
        PG8_STAGE(PG8_SB(1, 0), cB + kstep, voffB); PG8_STAGE(PG8_SA(1, 0), cA + kstep, voffA); PG8_STAGE(PG8_SB(1, 1), cB + hstep + kstep, voffB);
        PG8_WAIT_V(6); PG8_BAR;
    }
    for (;;) {
        const bool has_next = S.next(ui + 1, nxt);
        const char* nA = has_next ? (const char*)g.A + (size_t)nxt.pm * tstep : cA; const char* nB = has_next ? (const char*)g.Bt + (size_t)nxt.pn * tstep : cB;
        for (int t = 0; t < nt; t += 2) {
            if constexpr (Epi::KHOOK) { if (t != 0 && (t & 7) == 0) E.hook_scale(acc, lds, ui, (t >> 3) - 1, wr); }
            const bool last = (t == nt - 2);
            const char* a1 = cA + (size_t)(t + 1) * kstep;
            const char* a2 = last ? nA : cA + (size_t)(t + 2) * kstep; const char* b2 = last ? nB : cB + (size_t)(t + 2) * kstep;
            const char* a3 = a2 + kstep; const char* b3 = b2 + kstep;
            if (last && has_next) S.a_ready(nxt);
            if constexpr (SP2) {
            PG8_LDB(B0, 0, 0); PG8_LDB(B1, 0, 1); PG8_SCHED; PG8_LDA(At, 0, 0); PG8_STAGE(PG8_SA(1, 1), a1 + hstep, voffA);
            PG8_WAIT_V(8); PG8_WAIT_L(0); PG8_BAR; PG8_MMA(0, 0, At, B0); PG8_MMA(0, 1, At, B1); PG8_BAR; PG8_SCHED;
            PG8_LDA(At, 0, 1); PG8_STAGE(PG8_SB(0, 0), b2, voffB); PG8_STAGE(PG8_SB(0, 1), b2 + hstep, voffB); PG8_STAGE(PG8_SA(0, 0), a2, voffA);
            PG8_WAIT_V(8); PG8_WAIT_L(0); PG8_BAR; PG8_MMA(1, 0, At, B0); PG8_MMA(1, 1, At, B1); PG8_BAR; PG8_SCHED;
            PG8_LDB(B0, 1, 0); PG8_LDB(B1, 1, 1); PG8_SCHED; PG8_LDA(At, 1, 0); PG8_STAGE(PG8_SA(0, 1), a2 + hstep, voffA);
            PG8_WAIT_V(8); PG8_WAIT_L(0); PG8_BAR; PG8_MMA(0, 0, At, B0); PG8_MMA(0, 1, At, B1); PG8_BAR; PG8_SCHED;
            PG8_LDA(At, 1, 1); PG8_STAGE(PG8_SB(1, 0), b3, voffB); PG8_STAGE(PG8_SB(1, 1), b3 + hstep, voffB); PG8_STAGE(PG8_SA(1, 0), a3, voffA);
            PG8_WAIT_V(8); PG8_WAIT_L(0); PG8_BAR; PG8_MMA(1, 0, At, B0); PG8_MMA(1, 1, At, B1); PG8_BAR; PG8_SCHED;
            } else {
            PG8_LDB(B0, 0, 0); PG8_SCHED; PG8_LDA(At, 0, 0); PG8_STAGE(PG8_SA(1, 1), a1 + hstep, voffA);
            PG8_WAIT_L(8); PG8_BAR; PG8_WAIT_L(0); PG8_MMA(0, 0, At, B0); PG8_BAR; PG8_SCHED;
            PG8_LDB(B1, 0, 1); PG8_STAGE(PG8_SB(0, 0), b2, voffB);
            PG8_BAR; PG8_WAIT_L(0); PG8_MMA(0, 1, At, B1); PG8_BAR;
            PG8_LDA(At, 0, 1); PG8_STAGE(PG8_SA(0, 0), a2, voffA);
            PG8_BAR; PG8_WAIT_L(0); PG8_MMA(1, 0, At, B0); PG8_BAR; PG8_SCHED;
            PG8_STAGE(PG8_SB(0, 1), b2 + hstep, voffB);
            PG8_WAIT_V(6); PG8_BAR; PG8_MMA(1, 1, At, B1); PG8_BAR;
            PG8_LDB(B0, 1, 0); PG8_SCHED; PG8_LDA(At, 1, 0); PG8_STAGE(PG8_SA(0, 1), a2 + hstep, voffA);
            PG8_WAIT_L(8); PG8_BAR; PG8_WAIT_L(0); PG8_MMA(0, 0, At, B0); PG8_BAR; PG8_SCHED;
            PG8_LDB(B1, 1, 1); PG8_STAGE(PG8_SB(1, 0), b3, voffB);
            PG8_BAR; PG8_WAIT_L(0); PG8_MMA(0, 1, At, B1); PG8_BAR;
            PG8_LDA(At, 1, 1); PG8_STAGE(PG8_SA(1, 0), a3, voffA);
            PG8_BAR; PG8_WAIT_L(0); PG8_MMA(1, 0, At, B0); PG8_BAR; PG8_SCHED;
            PG8_STAGE(PG8_SB(1, 1), b3 + hstep, voffB);
            PG8_WAIT_V(6); PG8_BAR; PG8_MMA(1, 1, At, B1); PG8_BAR;
            }
        }
        if constexpr (Epi::KHOOK) E.hook_scale(acc, lds, ui, (nt >> 3) - 1, wr);
        if constexpr (ALIGN_EPI) { if (wr == 0) PG8_BAR; }
        if constexpr (!Epi::AFTER_DRAIN) { int l2_; asm volatile("v_mbcnt_lo_u32_b32 %0, -1, 0\n\tv_mbcnt_hi_u32_b32 %0, -1, %0" : "=v"(l2_));
            run_epi(E, acc, cur, wr, wc, l2_ & 15, l2_ >> 4); S.done(cur); }
        if (!has_next) break;
#pragma unroll
        for (int a = 0; a < 2; ++a)
#pragma unroll
            for (int b = 0; b < 2; ++b)
#pragma unroll
                for (int m = 0; m < 4; ++m)
#pragma unroll
                    for (int n = 0; n < 2; ++n) acc[a][b][m][n] = (f32x4){0.f, 0.f, 0.f, 0.f};
        cur = nxt; cA = nA; cB = nB; ++ui;
        if constexpr (ALIGN_EPI) { if (wr == 1) PG8_BAR; }
    }
    PG8_WAIT_V(0);
    if constexpr (!ALIGN_EPI) { if (wr == 0) PG8_BAR; }
    PG8_BAR;
    if constexpr (Epi::AFTER_DRAIN) { E.fused(acc, cur, wr, wc, fr, fq, lds, wid, lane); S.done(cur); }
#undef PG8_SA
#undef PG8_SB
#undef PG8_STAGE
#undef PG8_LDA
#undef PG8_LDB
#undef PG8_MMA
#undef PG8_WAIT_V
#undef PG8_WAIT_L
#undef PG8_BAR
#undef PG8_SCHED
}
}

#define LAS __attribute__((address_space(3)))
#define XB_TMO      128
#define XB_XCNT(j)  (256  + 64 * (j))
#define XB_XSUB(j)  (1280 + 64 * (j))
#define XB_XGEN(j)  (2304 + 64 * (j))
#define XB_TOP      3328
#define XB_TOPGEN   3392
#define XCD_BAR_WORDS 3456
#define XB_SPIN_CAP (1u << 18)
__device__ __forceinline__ unsigned xb_ld(unsigned* p)              { return __hip_atomic_load(p, __ATOMIC_RELAXED, __HIP_MEMORY_SCOPE_AGENT); }
__device__ __forceinline__ unsigned xb_add(unsigned* p, unsigned v) { return __hip_atomic_fetch_add(p, v, __ATOMIC_RELAXED, __HIP_MEMORY_SCOPE_AGENT); }
__device__ __forceinline__ unsigned xb_xcc_id() { return (unsigned)__builtin_amdgcn_s_getreg((3 << 11) | 20) & 0xFu; }
#define XB_SPIN(cond, bar) do { unsigned _sp = 0; while (cond) { __builtin_amdgcn_s_sleep(1); \
    if ((++_sp & 255u) == 0u) { if (xb_ld(&(bar)[XB_TMO])) break; if (_sp > XB_SPIN_CAP) { atomicAdd(&(bar)[XB_TMO], 1u); break; } } } } while (0)
struct XcdBarrier { unsigned* bar; unsigned x; volatile LAS unsigned* st; };
__device__ __forceinline__ XcdBarrier xcd_barrier_post(unsigned* bar, volatile LAS unsigned* st) {
    XcdBarrier b; b.bar = bar; b.x = xb_xcc_id(); b.st = st;
    if (threadIdx.x == 0) (void)xb_add(&bar[XB_XCNT(b.x)], 1u);
    return b;
}
__device__ __forceinline__ void xcd_barrier_complete(unsigned* bar, unsigned x, unsigned& nloc, unsigned& nx) {
    const unsigned G = gridDim.x * gridDim.y * gridDim.z;
    unsigned sum, cnt, mine, sp = 0u;
    for (;;) {
        sum = 0u; cnt = 0u; mine = 0u;
#pragma unroll
        for (unsigned j = 0; j < 16; ++j) { const unsigned c = xb_ld(&bar[XB_XCNT(j)]); sum += c; cnt += (c > 0u) ? 1u : 0u; mine = (j == x) ? c : mine; }
        if (sum == G) break;
        __builtin_amdgcn_s_sleep(1);
        if ((++sp & 255u) == 0u) { if (xb_ld(&bar[XB_TMO])) break; if (sp > XB_SPIN_CAP) { atomicAdd(&bar[XB_TMO], 1u); break; } }
    }
    nloc = mine > 0u ? mine : 1u; nx = cnt > 0u ? cnt : 1u;
}
__device__ __forceinline__ void xcd_barrier(const XcdBarrier& b) {
    asm volatile("s_waitcnt vmcnt(0)" ::: "memory");
    __syncthreads();
    if (threadIdx.x == 0) {
        unsigned* bar = b.bar;
        __builtin_amdgcn_s_waitcnt(0);
        unsigned nloc = b.st[0], nx = b.st[1];
        if (nloc == 0u) { xcd_barrier_complete(bar, b.x, nloc, nx); b.st[0] = nloc; b.st[1] = nx; }
        const unsigned old = xb_add(&bar[XB_XSUB(b.x)], 1u);
        const unsigned gen = old / nloc;
        if (old + 1u == (gen + 1u) * nloc) {
            __builtin_amdgcn_fence(__ATOMIC_RELEASE, "agent");
            asm volatile("s_waitcnt vmcnt(0)" ::: "memory");
            const unsigned og = xb_add(&bar[XB_TOP], 1u);
            const unsigned tg = og / nx;
            if (og + 1u == (tg + 1u) * nx) xb_add(&bar[XB_TOPGEN], 1u);
            else XB_SPIN(xb_ld(&bar[XB_TOPGEN]) == tg, bar);
            __builtin_amdgcn_fence(__ATOMIC_ACQUIRE, "agent");
            xb_add(&bar[XB_XGEN(b.x)], 1u);
            asm volatile("s_waitcnt vmcnt(0)" ::: "memory");
        } else {
            XB_SPIN(xb_ld(&bar[XB_XGEN(b.x)]) == gen, bar);
            __builtin_amdgcn_fence(__ATOMIC_ACQUIRE, "agent");
            asm volatile("s_waitcnt vmcnt(0)" ::: "memory");
        }
    }
    __syncthreads();
}


namespace ret {
typedef short v4i16_t __attribute__((ext_vector_type(4)));
constexpr int QP = 528, KSP = 544, VP = 144, OSP = 68;
constexpr int L_QS = 0, L_KS = 64 * QP, L_VS = 64 * QP + 64 * KSP, L_PS = L_VS + 64 * VP, L_OS0 = L_PS + 64 * VP, L_OS1 = L_OS0 + 64 * OSP * 4, L_END = L_OS1 + 64 * OSP * 4;
static_assert(L_END <= 131072 && (L_KS % 16) == 0 && (L_VS % 16) == 0 && (L_PS % 16) == 0 && (L_OS0 % 16) == 0 && (L_OS1 % 16) == 0, "retention LDS map");
__device__ __forceinline__ v4i16_t trrd(LAS const unsigned char* p) { return __builtin_amdgcn_ds_read_tr16_b64_v4i16((LAS v4i16_t*)p); }
__device__ __forceinline__ bf16x8 cat8(v4i16_t lo, v4i16_t hi) { return (bf16x8){lo[0], lo[1], lo[2], lo[3], hi[0], hi[1], hi[2], hi[3]}; }

__device__ __forceinline__ void scores_phase(LAS unsigned char* l3, const bf16_t* Q, const bf16_t* K, bf16_t* PP, int tid, int G, int bx) {
    const int lane = tid & 63, wid = __builtin_amdgcn_readfirstlane(tid >> 6), r = lane & 15, q4 = lane >> 4, tt = wid >> 1, st0 = 2 * (wid & 1);
    constexpr int NCHH = BATCH * RH * NCH;
    u32x4 rq[4], rk[4];
#define SC_LOAD(ch) do { const int ch_ = (ch) < NCHH ? (ch) : NCHH - 1; const int cidx_ = ch_ & 63, h_ = (ch_ >> 6) & 3, b_ = ch_ >> 8; \
        const size_t row0_ = (size_t)b_ * SEQ + (size_t)cidx_ * CH; \
        _Pragma("unroll") for (int i = 0; i < 4; ++i) { const int p_ = tid + 512 * i, rw_ = p_ >> 5, c8_ = (p_ & 31) * 8; \
            rq[i] = *(const u32x4*)(Q + (row0_ + rw_) * 1024 + h_ * 256 + c8_); rk[i] = *(const u32x4*)(K + (row0_ + rw_) * 1024 + h_ * 256 + c8_); } } while (0)
    SC_LOAD(bx);
    for (int ch = bx; ch < NCHH; ch += G) {
        __syncthreads();
#pragma unroll
        for (int i = 0; i < 4; ++i) { const int p_ = tid + 512 * i, rw_ = p_ >> 5, c8_ = (p_ & 31) * 8;
            *(LAS u32x4*)(l3 + L_QS + rw_ * QP + c8_ * 2) = rq[i]; *(LAS u32x4*)(l3 + L_KS + rw_ * QP + c8_ * 2) = rk[i]; }
        SC_LOAD(ch + G);
        __syncthreads();
        const int h_ = (ch >> 6) & 3; const float l2g = ret_l2g(h_);
        f32x4 d0 = {0.f, 0.f, 0.f, 0.f}, d1 = {0.f, 0.f, 0.f, 0.f};
#pragma unroll
        for (int ks = 0; ks < 8; ++ks) {
            const bf16x8 a = *(LAS const bf16x8*)(l3 + L_QS + (16 * tt + r) * QP + (32 * ks + 8 * q4) * 2);
            LAS const unsigned char* kp0 = l3 + L_KS + (16 * st0 + r) * QP + (32 * ks + 4 * q4) * 2;
            const u32x2 l0 = *(LAS const u32x2*)kp0, h0 = *(LAS const u32x2*)(kp0 + 32), l1 = *(LAS const u32x2*)(kp0 + 16 * QP), h1 = *(LAS const u32x2*)(kp0 + 16 * QP + 32);
            const u32x4 w0 = {l0.x, l0.y, h0.x, h0.y}, w1 = {l1.x, l1.y, h1.x, h1.y};
            d0 = __builtin_amdgcn_mfma_f32_16x16x32_bf16(a, __builtin_bit_cast(bf16x8, w0), d0, 0, 0, 0);
            d1 = __builtin_amdgcn_mfma_f32_16x16x32_bf16(a, __builtin_bit_cast(bf16x8, w1), d1, 0, 0, 0);
        }
        bf16_t* pp = PP + (size_t)ch * 4096;
#pragma unroll
        for (int g = 0; g < 4; ++g) { const int t = 16 * tt + 4 * q4 + g, s0 = 16 * st0 + r, s1 = s0 + 16;
            pp[t * 64 + s0] = (bf16_t)f2bf(d0[g] * ret_pfac(l2g, t, s0)); pp[t * 64 + s1] = (bf16_t)f2bf(d1[g] * ret_pfac(l2g, t, s1)); }
    }
#undef SC_LOAD
    __syncthreads();
}

__device__ __forceinline__ void scan_phase(LAS unsigned char* l3, const bf16_t* Q, const bf16_t* K, const bf16_t* Vd, bf16_t* GY, const bf16_t* PP, float* ssh, int tid, int bx) {
    const int lane = tid & 63, wid = __builtin_amdgcn_readfirstlane(tid >> 6), dkh = wid >> 2, dvq = wid & 3, r = lane & 15, q4 = lane >> 4;
    const int pair = (bx & 7) * 4 + (bx >> 6), slice = (bx >> 3) & 7, b = pair >> 2, h = pair & 3;
    const float l2g = ret_l2g(h), sdec = exp2f(l2g * 64.f);
    const int ft = tid >> 3, fd8 = (tid & 7) * 8;
    const float qdec = exp2f(l2g * (float)(ft + 1));
    f32x4 S[8];
#pragma unroll
    for (int i = 0; i < 8; ++i) S[i] = (f32x4){0.f, 0.f, 0.f, 0.f};
    const bf16_t* qg = Q + (size_t)b * SEQ * 1024 + h * 256; const bf16_t* kg = K + (size_t)b * SEQ * 1024 + h * 256;
    const bf16_t* vg = Vd + (size_t)b * SEQ * 2048 + h * 512 + slice * 64; bf16_t* gg = GY + (size_t)b * SEQ * 2048 + h * 512 + slice * 64;
    const bf16_t* pg = PP + (size_t)((b * 4 + h) * 64) * 4096;
    float* ssp = ssh + (size_t)h * 8 + slice;
    u32x4 rqX[4], rkX[4], rvX, rpX, rgX, rqY[4], rkY[4], rvY, rpY, rgY;
#define RET_LOADK(rk, c) do { const size_t r0_ = (size_t)(c) * CH; \
        _Pragma("unroll") for (int i = 0; i < 4; ++i) { const int p_ = tid + 512 * i, rw_ = p_ >> 5, c8_ = (p_ & 31) * 8; rk[i] = *(const u32x4*)(kg + (r0_ + rw_) * 1024 + c8_); } } while (0)
#define RET_LOADQ(rq, rv, rp, c) do { const size_t r0_ = (size_t)(c) * CH; \
        _Pragma("unroll") for (int i = 0; i < 4; ++i) { const int p_ = tid + 512 * i, rw_ = p_ >> 5, c8_ = (p_ & 31) * 8; rq[i] = *(const u32x4*)(qg + (r0_ + rw_) * 1024 + c8_); } \
        rv = *(const u32x4*)(vg + (r0_ + ft) * 2048 + fd8); rp = *(const u32x4*)(pg + (size_t)(c) * 4096 + ft * 64 + fd8); } while (0)
#define RET_LOADG(rg, c) do { rg = *(const u32x4*)(gg + ((size_t)(c) * CH + ft) * 2048 + fd8); } while (0)
#define RET_STK(rk) do { _Pragma("unroll") for (int i = 0; i < 4; ++i) { const int p_ = tid + 512 * i, rw_ = p_ >> 5, c8_ = (p_ & 31) * 8; *(LAS u32x4*)(l3 + L_KS + rw_ * KSP + ((c8_ * 2) ^ (((rw_ >> 3) & 1) << 7))) = rk[i]; } } while (0)
#define RET_STQ(rq, rv, rp) do { _Pragma("unroll") for (int i = 0; i < 4; ++i) { const int p_ = tid + 512 * i, rw_ = p_ >> 5, c8_ = (p_ & 31) * 8; *(LAS u32x4*)(l3 + L_QS + rw_ * QP + c8_ * 2) = rq[i]; } \
        *(LAS u32x4*)(l3 + L_VS + ft * VP + fd8 * 2) = rv; *(LAS u32x4*)(l3 + L_PS + ft * VP + fd8 * 2) = rp; } while (0)
#define RET_CHUNK(c, rkC, rgC, rqN, rvN, rpN) do { \
          \
        RET_STK(rkC); RET_LOADK(rkC, ((c) + 2 < NCH ? (c) + 2 : NCH - 1)); \
        bf16x8 vb[2]; \
        _Pragma("unroll") for (int ks = 0; ks < 2; ++ks) { LAS const unsigned char* vp = l3 + L_VS + (32 * ks + 8 * q4 + (r >> 2)) * VP + (16 * dvq + 4 * (r & 3)) * 2; \
            vb[ks] = cat8(trrd(vp), trrd(vp + 4 * VP)); } \
        f32x4 O[4]; \
        _Pragma("unroll") for (int t4 = 0; t4 < 4; ++t4) { const bf16x8 a = *(LAS const bf16x8*)(l3 + L_PS + (16 * t4 + r) * VP + (32 * dkh + 8 * q4) * 2); \
            O[t4] = __builtin_amdgcn_mfma_f32_16x16x32_bf16(a, dkh ? vb[1] : vb[0], (f32x4){0.f, 0.f, 0.f, 0.f}, 0, 0, 0); } \
        _Pragma("unroll") for (int m = 0; m < 4; ++m) { \
            u32x4 sw; sw.x = pk2(S[2 * m][0], S[2 * m][1]); sw.y = pk2(S[2 * m][2], S[2 * m][3]); sw.z = pk2(S[2 * m + 1][0], S[2 * m + 1][1]); sw.w = pk2(S[2 * m + 1][2], S[2 * m + 1][3]); \
            const bf16x8 sb = __builtin_bit_cast(bf16x8, sw); \
            _Pragma("unroll") for (int t4 = 0; t4 < 4; ++t4) { const bf16x8 aq = *(LAS const bf16x8*)(l3 + L_QS + (16 * t4 + r) * QP + (128 * dkh + 32 * m + 8 * q4) * 2); \
                O[t4] = __builtin_amdgcn_mfma_f32_16x16x32_bf16(aq, sb, O[t4], 0, 0, 0); } \
        } \
        { LAS float* os = (LAS float*)(l3 + (dkh ? L_OS1 : L_OS0)); \
          _Pragma("unroll") for (int t4 = 0; t4 < 4; ++t4) _Pragma("unroll") for (int g = 0; g < 4; ++g) os[(16 * t4 + 4 * q4 + g) * OSP + 16 * dvq + r] = O[t4][g]; } \
        __syncthreads(); \
          \
        _Pragma("unroll") for (int i = 0; i < 8; ++i) { \
            S[i] = S[i] * sdec; \
            _Pragma("unroll") for (int ks = 0; ks < 2; ++ks) { LAS const unsigned char* kp = l3 + L_KS + (32 * ks + 8 * q4 + (r >> 2)) * KSP + (((128 * dkh + 16 * i + 4 * (r & 3)) * 2) ^ ((q4 & 1) << 7)); \
                S[i] = __builtin_amdgcn_mfma_f32_16x16x32_bf16(cat8(trrd(kp), trrd(kp + 4 * KSP)), vb[ks], S[i], 0, 0, 0); } \
        } \
        { const LAS float* o0 = (const LAS float*)(l3 + L_OS0) + ft * OSP + fd8; const LAS float* o1 = (const LAS float*)(l3 + L_OS1) + ft * OSP + fd8; \
          const f32x4 a0 = *(const LAS f32x4*)o0, a1 = *(const LAS f32x4*)(o0 + 4), b0 = *(const LAS f32x4*)o1, b1 = *(const LAS f32x4*)(o1 + 4); \
          const f32x4 x0 = (a0 + b0) * qdec, x1 = (a1 + b1) * qdec; \
          float part = (x0[0] * x0[0] + x0[1] * x0[1]) + (x0[2] * x0[2] + x0[3] * x0[3]) + (x1[0] * x1[0] + x1[1] * x1[1]) + (x1[2] * x1[2] + x1[3] * x1[3]); \
          part = addx<1>(part); part = addx<2>(part); part = addx<4>(part); \
          const size_t grow = (size_t)b * SEQ + (size_t)(c) * CH + ft; \
          if ((tid & 7) == 0) ssp[grow * 32] = part;                 \
          u32x4 w; w.x = pk2(bflo(rgC.x) * x0[0], bfhi(rgC.x) * x0[1]); w.y = pk2(bflo(rgC.y) * x0[2], bfhi(rgC.y) * x0[3]); \
          w.z = pk2(bflo(rgC.z) * x1[0], bfhi(rgC.z) * x1[1]); w.w = pk2(bflo(rgC.w) * x1[2], bfhi(rgC.w) * x1[3]); \
          *(u32x4*)(gg + ((size_t)(c) * CH + ft) * 2048 + fd8) = w; \
          RET_LOADG(rgC, ((c) + 2 < NCH ? (c) + 2 : (c))); } \
        RET_STQ(rqN, rvN, rpN); RET_LOADQ(rqN, rvN, rpN, ((c) + 3 < NCH ? (c) + 3 : NCH - 1)); \
        __syncthreads(); } while (0)
    RET_LOADQ(rqX, rvX, rpX, 0); RET_LOADK(rkX, 0); RET_LOADG(rgX, 0);
    RET_LOADQ(rqY, rvY, rpY, 1); RET_LOADK(rkY, 1); RET_LOADG(rgY, 1);
    RET_STQ(rqX, rvX, rpX); RET_LOADQ(rqX, rvX, rpX, 2);
    __syncthreads();
    for (int c = 0; c < NCH; c += 2) {
        RET_CHUNK(c, rkX, rgX, rqY, rvY, rpY);
        RET_CHUNK(c + 1, rkY, rgY, rqX, rvX, rpX);
    }
#undef RET_CHUNK
#undef RET_LOADK
#undef RET_LOADQ
#undef RET_LOADG
#undef RET_STK
#undef RET_STQ
}
__device__ __forceinline__ void norm_phase(bf16_t* GY, const float* ssh, int tid, int G, int bx) {
    for (size_t i = ((size_t)bx * 512 + tid) * 8; i < (size_t)MTOK * 2048; i += (size_t)G * 512 * 8) {
        const size_t m = i >> 11; const int h = (int)((i & 2047) >> 9);
        const f32x4 q0 = *(const f32x4*)(ssh + (m * 4 + h) * 8), q1 = *(const f32x4*)(ssh + (m * 4 + h) * 8 + 4);
        const float rr = rstd_of(((q0[0] + q0[1]) + (q0[2] + q0[3])) + ((q1[0] + q1[1]) + (q1[2] + q1[3])), 1.f / 512.f);
        const u32x4 y = *(const u32x4*)(GY + i); u32x4 w;
        w.x = pk2(bflo(y.x) * rr, bfhi(y.x) * rr); w.y = pk2(bflo(y.y) * rr, bfhi(y.y) * rr); w.z = pk2(bflo(y.z) * rr, bfhi(y.z) * rr); w.w = pk2(bflo(y.w) * rr, bfhi(y.w) * rr);
        *(u32x4*)(GY + i) = w;
    }
}
}


namespace att {
typedef float f32x16 __attribute__((ext_vector_type(16)));
constexpr int KP = 144;
constexpr int VPA = 192;
constexpr int L_K = 0, L_V = 4 * 64 * KP, L_TB = 4 * 64 * KP + 4 * 64 * VPA, TBN = 384;
__device__ __forceinline__ void attention_phase(LAS unsigned char* l3, const bf16_t* Q2, const bf16_t* K2, const bf16_t* V2, const float* rel_bias, const float* qgain, const float* kgain, bf16_t* O2, int tid, int bx) {
    const int lane = tid & 63, wid = __builtin_amdgcn_readfirstlane(tid >> 6), r32 = lane & 31, hi = lane >> 5;
    const int b = bx & 7, h = bx >> 4, c4base = ((bx >> 3) & 1) * 8;
    LAS float* TB = (LAS float*)(l3 + L_TB);
    float gq = fabsf(qgain[lane]), gk = fabsf(kgain[lane]), bm = -1e30f;
    for (int j = lane; j < RELT; j += 64) bm = fmaxf(bm, rel_bias[h * RELT + j]);
#define ATT_WMAX(x) do { x = maxx<1>(x); x = maxx<2>(x); x = maxx<4>(x); x = maxx<8>(x); x = maxx<16>(x); x = maxx<32>(x); } while (0)
    ATT_WMAX(gq); ATT_WMAX(gk); ATT_WMAX(bm);
#undef ATT_WMAX
    const float shift = LOG2E * (8.08f * gq * gk + bm);
    __syncthreads();
    for (int u = tid; u < TBN; u += 512) { const int dist = u - 63; TB[u] = rel_bias[h * RELT + (dist > RELCLIP ? RELCLIP : dist) + RELCLIP] * LOG2E - shift; }
    const float cfar = rel_bias[h * RELT + 2 * RELCLIP] * LOG2E - shift;
    __syncthreads();
    const int sr = tid >> 3, sc8 = (tid & 7) * 8;
    const int qi_l = wid >> 1;
    const int qr = 32 * (wid & 1) + r32;
    const int i16 = lane & 15, g4 = lane >> 4;
    for (int ui = 0; ui < 8; ++ui) {
        const int c4 = c4base + ui, qi = 4 * c4 + qi_l;
        const int kc_lo = (4 * c4 - PAST) < 0 ? 0 : 4 * c4 - PAST, npairs = (4 * c4 + 4 - kc_lo) >> 1;
        const size_t qrow = (size_t)b * SEQ + (size_t)qi * CH + qr;
        bf16x8 qf[4];
#pragma unroll
        for (int ks = 0; ks < 4; ++ks) qf[ks] = *(const bf16x8*)(Q2 + qrow * 1024 + h * 64 + 16 * ks + 8 * hi);
        f32x16 o0, o1; float lsum = 0.f;
#pragma unroll
        for (int g = 0; g < 16; ++g) { o0[g] = 0.f; o1[g] = 0.f; }
        const bf16_t* kbase = K2 + (size_t)b * SEQ * 1024 + h * 64 + (size_t)sr * 1024 + sc8;
        const bf16_t* vbase = V2 + (size_t)b * SEQ * 1024 + h * 64 + (size_t)sr * 1024 + sc8;
        u32x4 rk[2], rv[2];
#pragma unroll
        for (int t = 0; t < 2; ++t) { rk[t] = *(const u32x4*)(kbase + (size_t)(kc_lo + t) * CH * 1024); rv[t] = *(const u32x4*)(vbase + (size_t)(kc_lo + t) * CH * 1024); }
        for (int kp = 0; kp < npairs; ++kp) {
            const int pbo = (kp & 1) * 2 * 64 * KP, pbv = (kp & 1) * 2 * 64 * VPA;
#pragma unroll
            for (int t = 0; t < 2; ++t) { *(LAS u32x4*)(l3 + L_K + pbo + t * 64 * KP + sr * KP + sc8 * 2) = rk[t]; *(LAS u32x4*)(l3 + L_V + pbv + t * 64 * VPA + sr * VPA + sc8 * 2) = rv[t]; }
            { const int kn = kc_lo + 2 * ((kp + 1 < npairs) ? kp + 1 : kp);
#pragma unroll
              for (int t = 0; t < 2; ++t) { rk[t] = *(const u32x4*)(kbase + (size_t)(kn + t) * CH * 1024); rv[t] = *(const u32x4*)(vbase + (size_t)(kn + t) * CH * 1024); } }
            __syncthreads();
            const int dcA = qi - (kc_lo + 2 * kp), dcB = dcA - 1;
            const bool actA = dcA >= 0 && dcA <= PAST, actB = dcB >= 0 && dcB <= PAST;
            if (actA || actB) {
                f32x16 p[2][2];
#pragma unroll
                for (int t = 0; t < 2; ++t) {
                    const int dc = t ? dcB : dcA; const bool act = t ? actB : actA;
                    if (act && dc <= 4) {
                        const LAS float* tb = TB + (64 * dc + qr + 63 - 4 * hi - 59);
#pragma unroll
                        for (int g = 0; g < 16; ++g) { p[t][0][g] = tb[59 - ((g & 3) + 8 * (g >> 2))]; p[t][1][g] = tb[59 - (32 + (g & 3) + 8 * (g >> 2))]; }
                    } else {
                        const float cv = act ? cfar : -INFINITY;
#pragma unroll
                        for (int g = 0; g < 16; ++g) { p[t][0][g] = cv; p[t][1][g] = cv; }
                    }
                }
#pragma unroll
                for (int t = 0; t < 2; ++t) {
                    LAS const unsigned char* kb = l3 + L_K + pbo + t * 64 * KP;
#pragma unroll
                    for (int ks = 0; ks < 4; ++ks) {
                        const bf16x8 k0 = *(LAS const bf16x8*)(kb + r32 * KP + (16 * ks + 8 * hi) * 2), k1 = *(LAS const bf16x8*)(kb + (32 + r32) * KP + (16 * ks + 8 * hi) * 2);
                        p[t][0] = __builtin_amdgcn_mfma_f32_32x32x16_bf16(k0, qf[ks], p[t][0], 0, 0, 0);
                        p[t][1] = __builtin_amdgcn_mfma_f32_32x32x16_bf16(k1, qf[ks], p[t][1], 0, 0, 0);
                    }
                }
#pragma unroll
                for (int t = 0; t < 2; ++t) {
                    float ls = 0.f;
#pragma unroll
                    for (int g = 0; g < 16; ++g) { p[t][0][g] = __builtin_amdgcn_exp2f(p[t][0][g]); p[t][1][g] = __builtin_amdgcn_exp2f(p[t][1][g]); ls += p[t][0][g] + p[t][1][g]; }
                    lsum += ls;
                    bf16x8 pf[2][2];
#pragma unroll
                    for (int n = 0; n < 2; ++n)
#pragma unroll
                        for (int s2 = 0; s2 < 2; ++s2) { u32x4 w; w.x = pk2(p[t][n][8 * s2 + 0], p[t][n][8 * s2 + 1]); w.y = pk2(p[t][n][8 * s2 + 2], p[t][n][8 * s2 + 3]);
                            w.z = pk2(p[t][n][8 * s2 + 4], p[t][n][8 * s2 + 5]); w.w = pk2(p[t][n][8 * s2 + 6], p[t][n][8 * s2 + 7]); pf[n][s2] = __builtin_bit_cast(bf16x8, w); }
                    LAS const unsigned char* vp = l3 + L_V + pbv + t * 64 * VPA + (4 * (g4 >> 1) + (i16 >> 2)) * VPA + (16 * (g4 & 1) + 4 * (i16 & 3)) * 2;
#pragma unroll
                    for (int n = 0; n < 2; ++n)
#pragma unroll
                        for (int s2 = 0; s2 < 2; ++s2) {
                            LAS const unsigned char* vq = vp + (32 * n + 16 * s2) * VPA;
                            const bf16x8 a0 = ret::cat8(ret::trrd(vq), ret::trrd(vq + 8 * VPA)), a1 = ret::cat8(ret::trrd(vq + 64), ret::trrd(vq + 8 * VPA + 64));
                            o0 = __builtin_amdgcn_mfma_f32_32x32x16_bf16(a0, pf[n][s2], o0, 0, 0, 0);
                            o1 = __builtin_amdgcn_mfma_f32_32x32x16_bf16(a1, pf[n][s2], o1, 0, 0, 0);
                        }
                }
            }
        }
        lsum = addx<32>(lsum);
        const float il = 1.0f / lsum;
        bf16_t* op = O2 + qrow * 1024 + h * 64 + 4 * hi;
#pragma unroll
        for (int k4 = 0; k4 < 4; ++k4) {
            u32x2 w; w.x = pk2(o0[4 * k4] * il, o0[4 * k4 + 1] * il); w.y = pk2(o0[4 * k4 + 2] * il, o0[4 * k4 + 3] * il); *(u32x2*)(op + 8 * k4) = w;
            u32x2 z; z.x = pk2(o1[4 * k4] * il, o1[4 * k4 + 1] * il); z.y = pk2(o1[4 * k4 + 2] * il, o1[4 * k4 + 3] * il); *(u32x2*)(op + 32 + 8 * k4) = z;
        }
        __syncthreads();
    }
}
}

__device__ __forceinline__ int phase_tid(int wave) { int ln_; asm volatile("v_mbcnt_lo_u32_b32 %0, -1, 0\n\tv_mbcnt_hi_u32_b32 %0, -1, %0" : "=v"(ln_)); return wave * 64 + ln_; }
constexpr int NPH = 13;
constexpr int CW_BAR = 4096;
constexpr int RING_BYTES = 131072, LDSCTL_OFF = RING_BYTES, MISC_OFF = LDSCTL_OFF + 320, LDS_BYTES = 147456;
struct MArgs { Ptrs P; };
typedef const __attribute__((address_space(4))) Ptrs* KPtrs;
#if defined(PROBE_MASK)
#define PROBE_STAMP(k) do { if (threadIdx.x == 0) ((volatile LAS unsigned*)(l3 + MISC_OFF + 64))[(k) + 1] = (unsigned)__builtin_amdgcn_s_memrealtime(); } while (0)
#else
#define PROBE_STAMP(k) do { } while (0)
#endif
#define PHASE_BEGIN { KPtrs kq = kp0; asm volatile("" : "+s"(kq)); unsigned char* const ws = kq->ws; float* const outp = kq->out; (void)outp; \
        int bxl = (int)blockIdx.x; asm volatile("" : "+s"(bxl)); const int tl = phase_tid(wave); (void)tl; (void)bxl;
#define PHASE_END(k) } xcd_barrier(bar); PROBE_STAMP(k);
#define BFW(off) ((bf16_t*)(ws + (off)))
#define F32W(off) ((float*)(ws + (off)))
template <class Epi> __device__ __forceinline__ void gemm_run(LAS unsigned char* l3, const bf16_t* A, const bf16_t* Bt, int N, int K, const Epi& E, int tl, int bxl) {
    pg8::Gemm g{A, Bt, MTOK, N, K}; pg8::StaticOrder S; S.init(MTOK, N, 256, bxl);
    pg8::gemm_phase<Epi, pg8::StaticOrder, true, true>(l3, g, S, E, tl);
}
__global__ void __launch_bounds__(512, 2) mega(MArgs a_unused) {
    extern __shared__ __attribute__((aligned(16))) unsigned char lds[];
    LAS unsigned char* l3 = (LAS unsigned char*)lds;
    volatile LAS unsigned* MISC = (volatile LAS unsigned*)(l3 + MISC_OFF);
    const int wave = __builtin_amdgcn_readfirstlane((int)threadIdx.x >> 6);
    const KPtrs kp0 = (KPtrs)__builtin_amdgcn_kernarg_segment_ptr();
    for (int u = threadIdx.x; u < (LDS_BYTES - LDSCTL_OFF) / 4; u += 512) ((LAS unsigned*)(l3 + LDSCTL_OFF))[u] = 0u;
    __syncthreads();
    const XcdBarrier bar = xcd_barrier_post((unsigned*)(kp0->ws + WS_CTL) + CW_BAR, MISC + 8);
#if defined(PROBE_MASK)
    if (threadIdx.x == 0) ((volatile LAS unsigned*)(l3 + MISC_OFF + 64))[0] = (unsigned)__builtin_amdgcn_s_memrealtime();
#endif
    PHASE_BEGIN { Ptrs P; P.x = kq->x; P.a_norm_g = kq->a_norm_g; P.a_w_in = kq->a_w_in; P.a_gn_g = kq->a_gn_g; P.a_w_o = kq->a_w_o; P.a_ffn_norm_g = kq->a_ffn_norm_g; P.a_w_gu = kq->a_w_gu; P.a_w_down = kq->a_w_down;
        P.kv_norm_g = kq->kv_norm_g; P.w_kv = kq->w_kv; P.k_norm_g = kq->k_norm_g; P.b_norm_g = kq->b_norm_g; P.b_w_q = kq->b_w_q; P.b_q_norm_g = kq->b_q_norm_g; P.b_rel_bias = kq->b_rel_bias; P.b_w_o = kq->b_w_o;
        P.b_ffn_norm_g = kq->b_ffn_norm_g; P.b_w_gu = kq->b_w_gu; P.b_w_down = kq->b_w_down; P.out = outp; P.ws = ws;
        prologue_phase(P, (float*)(lds + wave * 16384), bxl * 8 + wave, 256 * 8, tl & 63); } PHASE_END(0)
    PHASE_BEGIN { EpiIn E{F32W(WS_SS0), (const unsigned*)(ws + WS_COS), BFW(WS_Q), BFW(WS_K), BFW(WS_V), BFW(WS_G)};
        gemm_run(l3, (const bf16_t*)outp, BFW(WS_W1), RIN, 1024, E, tl, bxl); } PHASE_END(1)
    PHASE_BEGIN ret::scores_phase(l3, BFW(WS_Q), BFW(WS_K), (bf16_t*)outp + (size_t)32 * MiB, tl, 256, bxl); PHASE_END(2)
    PHASE_BEGIN ret::scan_phase(l3, BFW(WS_Q), BFW(WS_K), BFW(WS_V), BFW(WS_G), (const bf16_t*)outp + (size_t)32 * MiB, F32W(WS_SSH), tl, bxl); PHASE_END(3)
    PROBE_STAMP(4);
    PHASE_BEGIN { EpiRes<true> E{kq->x, nullptr, nullptr, BFW(WS_XH1), F32W(WS_SS1), F32W(WS_SSH)}; gemm_run(l3, BFW(WS_G), BFW(WS_W2), 1024, 2048, E, tl, bxl); } PHASE_END(5)
    PHASE_BEGIN { EpiGU E{F32W(WS_SS1), BFW(WS_H)}; gemm_run(l3, BFW(WS_XH1), BFW(WS_W3), 2 * FF, 1024, E, tl, bxl); } PHASE_END(6)
    PHASE_BEGIN { EpiResP E{BFW(WS_XH1), nullptr, BFW(WS_XH2), F32W(WS_SS2)}; gemm_run(l3, BFW(WS_H), BFW(WS_W4), 1024, FF, E, tl, bxl); } PHASE_END(7)
    PHASE_BEGIN { EpiKVQ E{F32W(WS_SS2), kq->k_norm_g, kq->b_q_norm_g, BFW(WS_K2), BFW(WS_V2), BFW(WS_Q2)}; gemm_run(l3, BFW(WS_XH2), BFW(WS_W5), 3072, 1024, E, tl, bxl); } PHASE_END(8)
    PHASE_BEGIN att::attention_phase(l3, BFW(WS_Q2), BFW(WS_K2), BFW(WS_V2), kq->b_rel_bias, kq->b_q_norm_g, kq->k_norm_g, BFW(WS_O2), tl, bxl); PHASE_END(9)
    PHASE_BEGIN { EpiResP E{BFW(WS_XH2), nullptr, BFW(WS_XH3), F32W(WS_SS3)}; gemm_run(l3, BFW(WS_O2), BFW(WS_W6), 1024, 1024, E, tl, bxl); } PHASE_END(10)
    PHASE_BEGIN { EpiGU E{F32W(WS_SS3), BFW(WS_H)}; gemm_run(l3, BFW(WS_XH3), BFW(WS_W7), 2 * FF, 1024, E, tl, bxl); } PHASE_END(11)
    PHASE_BEGIN { EpiResP E{BFW(WS_XH3), outp, nullptr, nullptr}; gemm_run(l3, BFW(WS_H), BFW(WS_W8), 1024, FF, E, tl, bxl); } } PROBE_STAMP(12);
#if defined(PROBE_MASK)
    if (blockIdx.x == 0 && threadIdx.x == 0) { volatile LAS unsigned* ts_ = (volatile LAS unsigned*)(l3 + MISC_OFF + 64); unsigned acc_ = 0u;
        for (int k = 0; k < NPH; ++k) if ((PROBE_MASK >> k) & 1) acc_ += ts_[k + 1] - ts_[k];
        const unsigned t_end = (unsigned)__builtin_amdgcn_s_memrealtime(); while ((unsigned)__builtin_amdgcn_s_memrealtime() - t_end < acc_) __builtin_amdgcn_s_sleep(8); }
#endif
}
extern "C" void kernel_launch(void* const* d_in, const int* in_sizes, int n_in, void* d_out, int out_size, void* d_ws, size_t ws_size, hipStream_t stream) {
    if (n_in != 19 || ws_size < WS_END || out_size != MTOK * DM) { fprintf(stderr, "kernel_launch: unexpected shapes (n_in %d, ws %zu, out %d)\n", n_in, ws_size, out_size); return; }
    MArgs a{};
    const float** pp = (const float**)&a.P;
    for (int i = 0; i < 19; ++i) pp[i] = (const float*)d_in[i];
    a.P.out = (float*)d_out; a.P.ws = (unsigned char*)d_ws;
    static int grid = 0;
    if (!grid) {
        if (hipFuncSetAttribute((const void*)mega, hipFuncAttributeMaxDynamicSharedMemorySize, LDS_BYTES) != hipSuccess) fprintf(stderr, "kernel_launch: hipFuncSetAttribute(mega) failed\n");
        int dev = 0, cus = 0, per_cu = 0; (void)hipGetDevice(&dev); (void)hipDeviceGetAttribute(&cus, hipDeviceAttributeMultiprocessorCount, dev);
        (void)hipOccupancyMaxActiveBlocksPerMultiprocessor(&per_cu, (const void*)mega, 512, LDS_BYTES);
        if (per_cu < 1 || cus < 256) fprintf(stderr, "kernel_launch: built for 256 CUs with one 512-thread workgroup each (device: %d CUs, occupancy query %d per CU)\n", cus, per_cu);
        (void)hipGetLastError();
        grid = 256;
    }
    (void)hipMemsetAsync(d_ws, 0, ZERO_BYTES, stream);
    void* args[] = {(void*)&a};
    if (hipLaunchCooperativeKernel((const void*)mega, dim3(grid), dim3(512), args, LDS_BYTES, stream) != hipSuccess) {
        (void)hipGetLastError(); fprintf(stderr, "kernel_launch: cooperative launch refused; plain launch of the same grid\n");
        hipLaunchKernelGGL(mega, dim3(grid), dim3(512), LDS_BYTES, stream, a);
    }
    const hipError_t e = hipPeekAtLastError();
    if (e != hipSuccess) fprintf(stderr, "kernel_launch: launch failed: %s\n", hipGetErrorName(e));
}
```
